# Optimizing an MI355X kernel written in HIP

```python
import math
import jax, jax.numpy as jnp
from jax import lax
import numpy as np

D_MODEL = 1024
BATCH = 8
SEQ = 4096
DEPTH = 1

CHUNK = 64
Q_BLOCK = 128
D_MIX = D_MODEL
D_ATT = D_MIX // 2
D_RNN = D_MIX - D_ATT
N_ATT_HEADS = 4
ATT_HEAD_DIM = D_ATT // (2 * N_ATT_HEADS)
ATT_V_DIM = 2 * ATT_HEAD_DIM
N_RNN_BLOCKS = 8
RNN_BLOCK = D_RNN // N_RNN_BLOCKS
CONV_WIDTH = 4
RGLRU_C = 8.0
D_FF = 2816
N_SUB = 3
W_IN_COLS = 3 * D_ATT + 2 * D_RNN
EPS = 1e-6

kernel_name = "hybrid_diffattn_rglru_macaron_adaln"


def _rmsnorm(x, g):
    xf = x.astype(jnp.float32)
    y = xf * lax.rsqrt(jnp.mean(xf * xf, axis=-1, keepdims=True) + EPS)
    return (y * g.astype(jnp.float32)).astype(x.dtype)


def _modulate(h, shift, scale):
    return h * (1.0 + scale[:, None, :]) + shift[:, None, :]


def _swiglu(h, w_gate, w_up, w_down):
    return (jax.nn.silu(h @ w_gate) * (h @ w_up)) @ w_down


def _alibi_slopes(n_heads):
    return 2.0 ** (-8.0 * (jnp.arange(n_heads, dtype=jnp.float32) + 1.0) / n_heads)


def _diff_attention(q, k, v, lam):
    S = q.shape[1]
    scale = ATT_HEAD_DIM ** -0.5
    slopes = _alibi_slopes(N_ATT_HEADS)
    outs = []
    for blk in range(S // Q_BLOCK):
        q0 = blk * Q_BLOCK
        kend = q0 + Q_BLOCK
        qb = q[:, q0:kend]
        kb = k[:, :kend]
        vb = v[:, :kend]
        s = jnp.einsum('bqhmd,bkhmd->bhmqk', qb, kb,
                       preferred_element_type=jnp.float32) * scale
        tq = jnp.arange(q0, kend)
        tk = jnp.arange(kend)
        dist = jnp.abs(tq[:, None] - tk[None, :]).astype(jnp.float32)
        allowed = (tk[None, :] // CHUNK) <= (tq[:, None] // CHUNK)
        s = s - slopes[None, :, None, None, None] * dist[None, None, None]
        s = jnp.where(allowed[None, None, None], s, -jnp.inf)
        p = jax.nn.softmax(s, axis=-1)
        a = p[:, :, 0] - lam * p[:, :, 1]
        outs.append(jnp.einsum('bhqk,bkhe->bqhe', a.astype(v.dtype), vb))
    return jnp.concatenate(outs, axis=1)


def _causal_depthwise_conv(x, w, b):
    S = x.shape[1]
    xp = jnp.pad(x, ((0, 0), (CONV_WIDTH - 1, 0), (0, 0)))
    y = xp[:, 0:S] * w[0]
    for i in range(1, CONV_WIDTH):
        y = y + xp[:, i:i + S] * w[i]
    return y + b


def _rglru(x, w_a, b_a, w_x, b_x, lru_lambda):
    B, S, _ = x.shape
    xf = x.astype(jnp.float32)
    xb = xf.reshape(B, S, N_RNN_BLOCKS, RNN_BLOCK)
    r = jax.nn.sigmoid(jnp.einsum('bsnc,ncd->bsnd', xb, w_a.astype(jnp.float32)).reshape(B, S, D_RNN)
                       + b_a.astype(jnp.float32))
    i = jax.nn.sigmoid(jnp.einsum('bsnc,ncd->bsnd', xb, w_x.astype(jnp.float32)).reshape(B, S, D_RNN)
                       + b_x.astype(jnp.float32))
    log_a = -RGLRU_C * r * jax.nn.softplus(-lru_lambda.astype(jnp.float32))
    a = jnp.exp(log_a)
    u = jnp.sqrt(-jnp.expm1(2.0 * log_a)) * (i * xf)

    def combine(left, right):
        a_l, u_l = left
        a_r, u_r = right
        return a_l * a_r, a_r * u_l + u_r

    _, h = lax.associative_scan(combine, (a, u), axis=1)
    return h.astype(x.dtype)


def setup_inputs(seed: int = 0) -> dict:
    key = jax.random.key(seed)
    ks = jax.random.split(key, 32)
    f32 = jnp.float32
    L = DEPTH
    nrm = lambda k, shape, s: jax.random.normal(k, shape, f32) * s
    u = jax.random.uniform(ks[20], (L, D_RNN), f32, 0.9, 0.999)
    sig_l = u ** (1.0 / RGLRU_C)
    lru_lambda = jnp.log(sig_l) - jnp.log1p(-sig_l)
    return {
        "x": nrm(ks[0], (BATCH, SEQ, D_MODEL), 1.0),
        "c": nrm(ks[1], (BATCH, D_MODEL), 1.0),
        "w_ada": nrm(ks[2], (L, D_MODEL, N_SUB * 3 * D_MODEL), 0.5 * D_MODEL ** -0.5),
        "b_ada": nrm(ks[3], (L, N_SUB * 3 * D_MODEL), 0.01),
        "g_norm": 1.0 + nrm(ks[4], (L, N_SUB, D_MODEL), 0.01),
        "ffn1_w_gate": nrm(ks[5], (L, D_MODEL, D_FF), D_MODEL ** -0.5),
        "ffn1_w_up": nrm(ks[6], (L, D_MODEL, D_FF), D_MODEL ** -0.5),
        "ffn1_w_down": nrm(ks[7], (L, D_FF, D_MODEL), D_FF ** -0.5),
        "w_in": nrm(ks[8], (L, D_MODEL, W_IN_COLS), D_MODEL ** -0.5),
        "q_norm_g": 1.0 + nrm(ks[9], (L, 2, ATT_HEAD_DIM), 0.01),
        "k_norm_g": 1.0 + nrm(ks[10], (L, 2, ATT_HEAD_DIM), 0.01),
        "lambda_params": nrm(ks[11], (L, 4, ATT_HEAD_DIM), 0.1),
        "head_norm_g": 1.0 + nrm(ks[12], (L, ATT_V_DIM), 0.01),
        "conv_w": nrm(ks[13], (L, CONV_WIDTH, D_RNN), CONV_WIDTH ** -0.5),
        "conv_b": nrm(ks[14], (L, D_RNN), 0.01),
        "w_rg_a": nrm(ks[15], (L, N_RNN_BLOCKS, RNN_BLOCK, RNN_BLOCK), RNN_BLOCK ** -0.5),
        "b_rg_a": nrm(ks[16], (L, D_RNN), 0.01),
        "w_rg_x": nrm(ks[17], (L, N_RNN_BLOCKS, RNN_BLOCK, RNN_BLOCK), RNN_BLOCK ** -0.5),
        "b_rg_x": nrm(ks[18], (L, D_RNN), 0.01),
        "lru_lambda": lru_lambda,
        "w_out": nrm(ks[19], (L, D_MIX, D_MODEL), D_MIX ** -0.5),
        "ffn2_w_gate": nrm(ks[21], (L, D_MODEL, D_FF), D_MODEL ** -0.5),
        "ffn2_w_up": nrm(ks[22], (L, D_MODEL, D_FF), D_MODEL ** -0.5),
        "ffn2_w_down": nrm(ks[23], (L, D_FF, D_MODEL), D_FF ** -0.5),
    }


def reference(x, c, w_ada, b_ada, g_norm, ffn1_w_gate, ffn1_w_up, ffn1_w_down,
              w_in, q_norm_g, k_norm_g, lambda_params, head_norm_g, conv_w, conv_b,
              w_rg_a, b_rg_a, w_rg_x, b_rg_x, lru_lambda, w_out,
              ffn2_w_gate, ffn2_w_up, ffn2_w_down):
    B, S, D = x.shape
    c_act = jax.nn.silu(c)
    for l in range(DEPTH):
        mod = (c_act @ w_ada[l] + b_ada[l]).reshape(B, N_SUB, 3, D)

        h = _modulate(_rmsnorm(x, g_norm[l, 0]), mod[:, 0, 0], mod[:, 0, 1])
        x = x + 0.5 * mod[:, 0, 2][:, None, :] * _swiglu(h, ffn1_w_gate[l], ffn1_w_up[l], ffn1_w_down[l])

        h = _modulate(_rmsnorm(x, g_norm[l, 1]), mod[:, 1, 0], mod[:, 1, 1])
        proj = h @ w_in[l]
        q = proj[..., 0:D_ATT].reshape(B, S, N_ATT_HEADS, 2, ATT_HEAD_DIM)
        k = proj[..., D_ATT:2 * D_ATT].reshape(B, S, N_ATT_HEADS, 2, ATT_HEAD_DIM)
        v = proj[..., 2 * D_ATT:3 * D_ATT].reshape(B, S, N_ATT_HEADS, ATT_V_DIM)
        gate_br = proj[..., 3 * D_ATT:3 * D_ATT + D_RNN]
        x_br = proj[..., 3 * D_ATT + D_RNN:]

        q = _rmsnorm(q, q_norm_g[l])
        k = _rmsnorm(k, k_norm_g[l])
        lam_init = 0.8 - 0.6 * math.exp(-0.3 * l)
        lp = lambda_params[l].astype(jnp.float32)
        lam = jnp.exp(jnp.sum(lp[0] * lp[1])) - jnp.exp(jnp.sum(lp[2] * lp[3])) + lam_init
        att = _diff_attention(q, k, v, lam)
        att = (_rmsnorm(att, head_norm_g[l]) * (1.0 - lam_init)).reshape(B, S, D_ATT)

        xr = _causal_depthwise_conv(x_br, conv_w[l], conv_b[l])
        hr = _rglru(xr, w_rg_a[l], b_rg_a[l], w_rg_x[l], b_rg_x[l], lru_lambda[l])
        rnn = jax.nn.gelu(gate_br) * hr

        mix = jnp.concatenate([att, rnn], axis=-1) @ w_out[l]
        x = x + mod[:, 1, 2][:, None, :] * mix

        h = _modulate(_rmsnorm(x, g_norm[l, 2]), mod[:, 2, 0], mod[:, 2, 1])
        x = x + 0.5 * mod[:, 2, 2][:, None, :] * _swiglu(h, ffn2_w_gate[l], ffn2_w_up[l], ffn2_w_down[l])
    return x
```

```cpp
#include <hip/hip_runtime.h>
#include <hip/hip_cooperative_groups.h>
#include <cstdio>
#include <cstdint>
namespace cg = cooperative_groups;
namespace pg8 {
#define PG8_LAS __attribute__((address_space(3)))
typedef unsigned short bf16_t;
typedef short bf16x8 __attribute__((ext_vector_type(8)));
typedef float f32x4 __attribute__((ext_vector_type(4)));
typedef unsigned u32x4 __attribute__((ext_vector_type(4)));
constexpr int BM = 256, BK = 64, HALF = 128, HTB = HALF * BK * 2  , STAGE_BYTES = 8 * HTB, NXCD = 8, WGM = 8;

__host__ __device__ __forceinline__ int lds_byte(int r, int c) { const int st = (r >> 4) * 2 + (c >> 5), rr = r & 15, cc = c & 31, ob = rr * 64 + cc * 2; return st * 1024 + (ob ^ (((ob >> 9) & 1) << 5)); }
__host__ __device__ __forceinline__ void stage_rc(int b, int& R, int& C) { const int st = b / 1024, sb = b % 1024, swz = sb ^ (((sb >> 9) & 1) << 5); R = (st >> 1) * 16 + swz / 64; C = (st & 1) * 32 + (swz % 64) / 2; }
__host__ __device__ __forceinline__ int perm32(int rho) { const int n = rho >> 4, i = rho & 15; return 8 * (i >> 2) + 4 * n + (i & 3); }

struct Unit { int pm, pn; };
struct Gemm { const bf16_t* A; const bf16_t* Bt; int M, N, K; };

struct StaticOrder {
    int nM, nN, nwg, G, c;
    __host__ __device__ void init(int M, int N, int G_, int c_) { nM = M / BM; nN = N / BM; nwg = nM * nN; G = G_; c = c_; }
    __host__ __device__ bool next(int i, Unit& u) const {
        const long L = (long)i * G + c; if (L >= nwg) return false;
        int wgid = (int)L; { const int q = nwg / NXCD, r = nwg % NXCD, xcd = wgid % NXCD, off = wgid / NXCD; wgid = (xcd < r ? xcd * (q + 1) : r * (q + 1) + (xcd - r) * q) + off; }
        const int nig = WGM * nN, gid = wgid / nig, fm = gid * WGM, gsz = (nM - fm) < WGM ? (nM - fm) : WGM;
        u.pm = fm + ((wgid % nig) % gsz); u.pn = (wgid % nig) / gsz; return true;
    }
    __device__ __forceinline__ void a_ready(const Unit&) const {}
    __device__ __forceinline__ void done(const Unit&) const {}
};


typedef unsigned u32x2 __attribute__((ext_vector_type(2)));
typedef float f32x2_t __attribute__((ext_vector_type(2))); typedef __bf16 bf16x2_t __attribute__((ext_vector_type(2)));
__device__ __forceinline__ unsigned pk_bf16(float lo, float hi) { f32x2_t v = {lo, hi}; bf16x2_t b = __builtin_convertvector(v, bf16x2_t); return __builtin_bit_cast(unsigned, b); }
__device__ __forceinline__ float sigmoid_f(float v) { return __builtin_amdgcn_rcpf(1.0f + __builtin_amdgcn_exp2f(v * -1.4426950408889634f)); }

__device__ __forceinline__ float row_rstd(const float* ssq, int row, int fq) {
    const f32x4 q = *(const f32x4*)(ssq + (size_t)row * 16 + 4 * fq);
    float s = (q[0] + q[1]) + (q[2] + q[3]); s += __shfl_xor(s, 16); s += __shfl_xor(s, 32);
    return __builtin_amdgcn_rsqf(s * (1.0f / 1024.0f) + 1e-6f);
}
__device__ __forceinline__ void row_rstd8(const float* ssq, int row0, int fq, float (&rs)[2][4]) {
    f32x4 q[2][4];
#pragma unroll
    for (int ai = 0; ai < 2; ++ai)
#pragma unroll
        for (int m = 0; m < 4; ++m) q[ai][m] = *(const f32x4*)(ssq + (size_t)(row0 + ai * HALF + m * 16) * 16 + 4 * fq);
#pragma unroll
    for (int ai = 0; ai < 2; ++ai)
#pragma unroll
        for (int m = 0; m < 4; ++m) { float s = (q[ai][m][0] + q[ai][m][1]) + (q[ai][m][2] + q[ai][m][3]); s += __shfl_xor(s, 16); s += __shfl_xor(s, 32); rs[ai][m] = __builtin_amdgcn_rsqf(s * (1.0f / 1024.0f) + 1e-6f); }
}
struct EpiSwiglu {
    static constexpr bool PERM = true, AFTER_DRAIN = false;
    bf16_t* O; const float* ssq; const float* sW;
    __device__ __forceinline__ void operator()(const f32x4 (&acc)[2][2][4][2], const Unit& u, int wr, int wc, int fr, int fq) const {
        const int row0 = u.pm * BM + wr * 64 + fr, col0 = u.pn * 128 + wc * 32 + 8 * fq, b = u.pm >> 4;
        const float* sw = sW + (size_t)b * 5632 + u.pn * BM + wc * 32 + 8 * fq;
        const f32x4 sg0 = *(const f32x4*)(sw), sg1 = *(const f32x4*)(sw + 4), su0 = *(const f32x4*)(sw + HALF), su1 = *(const f32x4*)(sw + HALF + 4);
        const f32x4 ng0 = sg0 * -1.4426950408889634f, ng1 = sg1 * -1.4426950408889634f;
        float rsv[2][4]; row_rstd8(ssq, row0, fq, rsv);
#pragma unroll
        for (int ai = 0; ai < 2; ++ai)
#pragma unroll
            for (int m = 0; m < 4; ++m) {
                const int row = row0 + ai * HALF + m * 16;
                const float rs = rsv[ai][m];
                bf16_t* rowp = O + (size_t)row * 2816 + col0;
                const f32x4 g0 = acc[ai][0][m][0] * rs + sg0, g1 = acc[ai][0][m][1] * rs + sg1, u0 = acc[ai][1][m][0] * rs + su0, u1 = acc[ai][1][m][1] * rs + su1;
                const float nrs = rs * -1.4426950408889634f;
                const f32x4 t0 = acc[ai][0][m][0] * nrs + ng0, t1 = acc[ai][0][m][1] * nrs + ng1;
                float h[8];
#pragma unroll
                for (int e = 0; e < 4; ++e) { h[e] = g0[e] * __builtin_amdgcn_rcpf(1.0f + __builtin_amdgcn_exp2f(t0[e])) * u0[e]; h[4 + e] = g1[e] * __builtin_amdgcn_rcpf(1.0f + __builtin_amdgcn_exp2f(t1[e])) * u1[e]; }
                u32x4 w; w.x = pk_bf16(h[0], h[1]); w.y = pk_bf16(h[2], h[3]); w.z = pk_bf16(h[4], h[5]); w.w = pk_bf16(h[6], h[7]);
                __builtin_nontemporal_store(w, (u32x4*)rowp);
            }
    }
};
template <bool NORM, bool HALFC, bool RES16, bool OUT16> struct EpiResid {
    static constexpr bool PERM = true, AFTER_DRAIN = false;
    const void* res; void* out; const float* gate;
    bf16_t* An; float* ssq; const float* gn; const float* scl;
    __device__ __forceinline__ void operator()(const f32x4 (&acc)[2][2][4][2], const Unit& u, int wr, int wc, int fr, int fq) const {
        const int row0 = u.pm * BM + wr * 64 + fr, col0 = u.pn * BM + wc * 32 + 8 * fq, b = u.pm >> 4;
        f32x4 gv[2][2], gs[2][2];
#pragma unroll
        for (int bj = 0; bj < 2; ++bj)
#pragma unroll
            for (int n = 0; n < 2; ++n) { gv[bj][n] = *(const f32x4*)(gate + (size_t)b * 9216 + col0 + bj * HALF + n * 4) * (HALFC ? 0.5f : 1.0f);
                if (NORM) gs[bj][n] = *(const f32x4*)(gn + col0 + bj * HALF + n * 4) * (*(const f32x4*)(scl + (size_t)b * 9216 + col0 + bj * HALF + n * 4) + 1.0f); }
        constexpr int GR = RES16 ? 4 : 2;
#pragma unroll
        for (int am = 0; am < 8 / GR; ++am) {
            const int ai = (am * GR) >> 2, m0 = (am * GR) & 3;
            f32x4 rr[RES16 ? 1 : GR][2][2]; u32x4 rw[RES16 ? GR : 1][2];
#pragma unroll
            for (int mm = 0; mm < GR; ++mm)
#pragma unroll
                for (int bj = 0; bj < 2; ++bj) { const size_t off = (size_t)(row0 + ai * HALF + (m0 + mm) * 16) * 1024 + col0 + bj * HALF;
                    if (RES16) rw[mm][bj] = *(const u32x4*)((const bf16_t*)res + off);
                    else { rr[mm][bj][0] = __builtin_nontemporal_load((const f32x4*)((const float*)res + off)); rr[mm][bj][1] = __builtin_nontemporal_load((const f32x4*)((const float*)res + off + 4)); } }
#pragma unroll
            for (int mm = 0; mm < GR; ++mm) {
                const int m = m0 + mm;
                const int row = row0 + ai * HALF + m * 16;
                const size_t off = (size_t)row * 1024 + col0;
                float ss = 0.f;
#pragma unroll
                for (int bj = 0; bj < 2; ++bj) {
                    f32x4 r0, r1;
                    if (RES16) { const u32x4 w = rw[mm][bj];
                        r0 = (f32x4){__uint_as_float(w.x << 16), __uint_as_float(w.x & 0xffff0000u), __uint_as_float(w.y << 16), __uint_as_float(w.y & 0xffff0000u)};
                        r1 = (f32x4){__uint_as_float(w.z << 16), __uint_as_float(w.z & 0xffff0000u), __uint_as_float(w.w << 16), __uint_as_float(w.w & 0xffff0000u)}; }
                    else { r0 = rr[mm][bj][0]; r1 = rr[mm][bj][1]; }
                    const f32x4 o0 = r0 + gv[bj][0] * acc[ai][bj][m][0], o1 = r1 + gv[bj][1] * acc[ai][bj][m][1];
                    if (OUT16) { u32x4 w; w.x = pk_bf16(o0[0], o0[1]); w.y = pk_bf16(o0[2], o0[3]); w.z = pk_bf16(o1[0], o1[1]); w.w = pk_bf16(o1[2], o1[3]); __builtin_nontemporal_store(w, (u32x4*)((bf16_t*)out + off + bj * HALF)); }
                    else { __builtin_nontemporal_store(o0, (f32x4*)((float*)out + off + bj * HALF)); __builtin_nontemporal_store(o1, (f32x4*)((float*)out + off + bj * HALF + 4)); }
                    if (NORM) { ss += ((o0[0] * o0[0] + o0[1] * o0[1]) + (o0[2] * o0[2] + o0[3] * o0[3])) + ((o1[0] * o1[0] + o1[1] * o1[1]) + (o1[2] * o1[2] + o1[3] * o1[3]));
                        const f32x4 a0 = o0 * gs[bj][0], a1 = o1 * gs[bj][1];
                        u32x4 w; w.x = pk_bf16(a0[0], a0[1]); w.y = pk_bf16(a0[2], a0[3]); w.z = pk_bf16(a1[0], a1[1]); w.w = pk_bf16(a1[2], a1[3]);
                        *(u32x4*)(An + off + bj * HALF) = w; } }
                if (NORM) { ss += __shfl_xor(ss, 16); ss += __shfl_xor(ss, 32); if (fq == 0) ssq[(size_t)row * 16 + 4 * u.pn + wc] = ss; }
            }
            asm volatile("" ::: "memory");
        }
    }
};
struct EpiWin {
    static constexpr bool PERM = true, AFTER_DRAIN = false;
    bf16_t* O; const float* gq; const float* gk; const float* ssq; const float* sW;
    __device__ __forceinline__ void operator()(const f32x4 (&acc)[2][2][4][2], const Unit& u, int wr, int wc, int fr, int fq) const {
        const int row0 = u.pm * BM + wr * 64 + fr, col0 = u.pn * BM + wc * 64 + 8 * fq;
        const float* sw = sW + (size_t)(u.pm >> 4) * 2560 + u.pn * BM + wc * 32 + 8 * fq;
        f32x4 sb[2][2];
#pragma unroll
        for (int bj = 0; bj < 2; ++bj)
#pragma unroll
            for (int n = 0; n < 2; ++n) sb[bj][n] = *(const f32x4*)(sw + bj * HALF + 4 * n);
        float rsv[2][4]; row_rstd8(ssq, row0, fq, rsv);
        if (u.pn < 4) {
            const float* g = (u.pn < 2 ? gq : gk) + (wc & 1) * 64 + 8 * fq;
            const float sc = (u.pn < 2) ? 0.125f * 1.4426950408889634f : 1.0f;
            f32x4 gv[2][2];
#pragma unroll
            for (int bj = 0; bj < 2; ++bj)
#pragma unroll
                for (int n = 0; n < 2; ++n) gv[bj][n] = *(const f32x4*)(g + 32 * bj + 4 * n) * sc;
#pragma unroll
            for (int ai = 0; ai < 2; ++ai)
#pragma unroll
                for (int m = 0; m < 4; ++m) {
                    const float rs = rsv[ai][m];
                    f32x4 xv[2][2];
                    float ss = 0.f;
#pragma unroll
                    for (int bj = 0; bj < 2; ++bj)
#pragma unroll
                        for (int n = 0; n < 2; ++n) { const f32x4 x = acc[ai][bj][m][n] * rs + sb[bj][n]; xv[bj][n] = x; ss += (x[0] * x[0] + x[1] * x[1]) + (x[2] * x[2] + x[3] * x[3]); }
                    ss += __shfl_xor(ss, 16); ss += __shfl_xor(ss, 32);
                    const float rstd = __builtin_amdgcn_rsqf(ss * (1.0f / 64.0f) + 1e-6f);
                    bf16_t* rowp = O + (size_t)(row0 + ai * HALF + m * 16) * 2560 + col0;
#pragma unroll
                    for (int bj = 0; bj < 2; ++bj) { const f32x4 v0 = xv[bj][0] * rstd * gv[bj][0], v1 = xv[bj][1] * rstd * gv[bj][1];
                        u32x4 w; w.x = pk_bf16(v0[0], v0[1]); w.y = pk_bf16(v0[2], v0[3]); w.z = pk_bf16(v1[0], v1[1]); w.w = pk_bf16(v1[2], v1[3]);
                        *(u32x4*)(rowp + 32 * bj) = w; }
                }
        } else {
#pragma unroll
            for (int ai = 0; ai < 2; ++ai)
#pragma unroll
                for (int m = 0; m < 4; ++m) {
                    const float rs = rsv[ai][m];
                    bf16_t* rowp = O + (size_t)(row0 + ai * HALF + m * 16) * 2560 + col0;
#pragma unroll
                    for (int bj = 0; bj < 2; ++bj) { const f32x4 v0 = acc[ai][bj][m][0] * rs + sb[bj][0], v1 = acc[ai][bj][m][1] * rs + sb[bj][1];
                        u32x4 w; w.x = pk_bf16(v0[0], v0[1]); w.y = pk_bf16(v0[2], v0[3]); w.z = pk_bf16(v1[0], v1[1]); w.w = pk_bf16(v1[2], v1[3]);
                        *(u32x4*)(rowp + 32 * bj) = w; }
                }
        }
    }
};

template <class Epi, class Sched, bool ALIGN_EPI = false, bool SP2 = false>
__device__ __forceinline__ void gemm_phase(PG8_LAS unsigned char* lds, const Gemm g, const Sched& S, const Epi& E) {
    int tid_l = threadIdx.x; asm volatile("" : "+v"(tid_l));
    const int tid = tid_l, wid = __builtin_amdgcn_readfirstlane(tid >> 6), lane = tid & 63, wr = wid >> 2, wc = wid & 3, fr = lane & 15, fq = lane >> 4;
    const int K = g.K, nt = K / BK;
    unsigned voffA[2], voffB[2];
#pragma unroll
    for (int i = 0; i < 2; ++i) { int R, C; stage_rc(tid * 16 + i * 8192, R, C); const int Rb = Epi::PERM ? ((R & ~31) + perm32(R & 31)) : R;
        voffA[i] = (unsigned)(R * K + C) * 2u; voffB[i] = (unsigned)(Rb * K + C) * 2u; }
    const size_t kstep = (size_t)(BK * 2);
    const size_t hstep = (size_t)HALF * K * 2;
    const size_t tstep = 2 * hstep;
    const unsigned ldsw = (unsigned)wid * 1024u;
    const int aoff = lds_byte(wr * 64 + fr, fq * 8), boff = lds_byte(wc * 32 + fr, fq * 8);
#define PG8_SA(b, h) (((b) * 2 + (h)) * HTB)
#define PG8_SB(b, h) ((4 + (b) * 2 + (h)) * HTB)
#define PG8_STAGE(bufoff, gbase, voff) do { _Pragma("unroll") for (int _i = 0; _i < 2; ++_i) \
        __builtin_amdgcn_global_load_lds((const unsigned*)((const char*)(gbase) + (voff)[_i]), (PG8_LAS unsigned*)(lds + (bufoff) + ldsw + _i * 8192), 16, 0, 0); } while (0)
#define PG8_LDA(dst, b, h) do { _Pragma("unroll") for (int m = 0; m < 4; ++m) _Pragma("unroll") for (int k = 0; k < 2; ++k) dst[m][k] = *(const PG8_LAS bf16x8*)(lds + PG8_SA(b, h) + aoff + m * 2048 + k * 1024); } while (0)
#define PG8_LDB(dst, b, h) do { _Pragma("unroll") for (int n = 0; n < 2; ++n) _Pragma("unroll") for (int k = 0; k < 2; ++k) dst[n][k] = *(const PG8_LAS bf16x8*)(lds + PG8_SB(b, h) + boff + n * 2048 + k * 1024); } while (0)
#define PG8_MMA(ai, bj, At, Bt) do { __builtin_amdgcn_s_setprio(1); _Pragma("unroll") for (int m = 0; m < 4; ++m) _Pragma("unroll") for (int n = 0; n < 2; ++n) _Pragma("unroll") for (int k = 0; k < 2; ++k) \
        acc[ai][bj][m][n] = __builtin_amdgcn_mfma_f32_16x16x32_bf16(Bt[n][k], At[m][k], acc[ai][bj][m][n], 0, 0, 0); __builtin_amdgcn_s_setprio(0); } while (0)
#define PG8_WAIT_V(n) asm volatile("s_waitcnt vmcnt(" #n ")" ::: "memory")
#define PG8_WAIT_L(n) asm volatile("s_waitcnt lgkmcnt(" #n ")" ::: "memory")
#define PG8_BAR __builtin_amdgcn_s_barrier()
#define PG8_SCHED __builtin_amdgcn_sched_barrier(0)
    Unit cur, nxt; int ui = 0;
    if (!S.next(0, cur)) return;
    f32x4 acc[2][2][4][2];
#pragma unroll
    for (int a = 0; a < 2; ++a)
#pragma unroll
        for (int b = 0; b < 2; ++b)
#pragma unroll
            for (int m = 0; m < 4; ++m)
#pragma unroll
                for (int n = 0; n < 2; ++n) acc[a][b][m][n] = (f32x4){0.f, 0.f, 0.f, 0.f};
    bf16x8 At[4][2], B0[2][2], B1[2][2];
    const char* cA = (const char*)g.A + (size_t)cur.pm * tstep; const char* cB = (const char*)g.Bt + (size_t)cur.pn * tstep;
    S.a_ready(cur);
    if constexpr (SP2) {
        PG8_STAGE(PG8_SB(0, 0), cB, voffB); PG8_STAGE(PG8_SB(0, 1), cB + hstep, voffB); PG8_STAGE(PG8_SA(0, 0), cA, voffA); PG8_STAGE(PG8_SA(0, 1), cA + hstep, voffA);
        if (wr == 1) PG8_BAR;
        PG8_WAIT_V(2); PG8_BAR;
        PG8_STAGE(PG8_SB(1, 0), cB + kstep, voffB); PG8_STAGE(PG8_SA(1, 0), cA + kstep, voffA); PG8_STAGE(PG8_SB(1, 1), cB + hstep + kstep, voffB);
        PG8_WAIT_V(6); PG8_BAR;
    } else {
        PG8_STAGE(PG8_SB(0, 0), cB, voffB); PG8_STAGE(PG8_SA(0, 0), cA, voffA); PG8_STAGE(PG8_SB(0, 1), cB + hstep, voffB); PG8_STAGE(PG8_SA(0, 1), cA + hstep, voffA);
        if (wr == 1) PG8_BAR;
        PG8_WAIT_V(4); PG8_BAR;
        PG8_STAGE(PG8_SB(1, 0), cB + kstep, voffB); PG8_STAGE(PG8_SA(1, 0), cA + kstep, voffA); PG8_STAGE(PG8_SB(1, 1), cB + hstep + kstep, voffB);
        PG8_WAIT_V(6); PG8_BAR;
    }
    for (;;) {
        const bool has_next = S.next(ui + 1, nxt);
        const char* nA = has_next ? (const char*)g.A + (size_t)nxt.pm * tstep : cA; const char* nB = has_next ? (const char*)g.Bt + (size_t)nxt.pn * tstep : cB;
        for (int t = 0; t < nt; t += 2) {
            const bool last = (t == nt - 2);
            const char* a1 = cA + (size_t)(t + 1) * kstep;
            const char* a2 = last ? nA : cA + (size_t)(t + 2) * kstep; const char* b2 = last ? nB : cB + (size_t)(t + 2) * kstep;
            const char* a3 = a2 + kstep; const char* b3 = b2 + kstep;
            if (last && has_next) S.a_ready(nxt);
            if constexpr (SP2) {
            PG8_LDB(B0, 0, 0); PG8_LDB(B1, 0, 1); PG8_SCHED; PG8_LDA(At, 0, 0); PG8_STAGE(PG8_SA(1, 1), a1 + hstep, voffA);
            PG8_WAIT_V(8); PG8_WAIT_L(0); PG8_BAR; PG8_MMA(0, 0, At, B0); PG8_MMA(0, 1, At, B1); PG8_BAR; PG8_SCHED;
            PG8_LDA(At, 0, 1); PG8_STAGE(PG8_SB(0, 0), b2, voffB); PG8_STAGE(PG8_SB(0, 1), b2 + hstep, voffB); PG8_STAGE(PG8_SA(0, 0), a2, voffA);
            PG8_WAIT_V(8); PG8_WAIT_L(0); PG8_BAR; PG8_MMA(1, 0, At, B0); PG8_MMA(1, 1, At, B1); PG8_BAR; PG8_SCHED;
            PG8_LDB(B0, 1, 0); PG8_LDB(B1, 1, 1); PG8_SCHED; PG8_LDA(At, 1, 0); PG8_STAGE(PG8_SA(0, 1), a2 + hstep, voffA);
            PG8_WAIT_V(8); PG8_WAIT_L(0); PG8_BAR; PG8_MMA(0, 0, At, B0); PG8_MMA(0, 1, At, B1); PG8_BAR; PG8_SCHED;
            PG8_LDA(At, 1, 1); PG8_STAGE(PG8_SB(1, 0), b3, voffB); PG8_STAGE(PG8_SB(1, 1), b3 + hstep, voffB); PG8_STAGE(PG8_SA(1, 0), a3, voffA);
            PG8_WAIT_V(8); PG8_WAIT_L(0); PG8_BAR; PG8_MMA(1, 0, At, B0); PG8_MMA(1, 1, At, B1); PG8_BAR; PG8_SCHED;
            } else {
            PG8_LDB(B0, 0, 0); PG8_SCHED; PG8_LDA(At, 0, 0); PG8_STAGE(PG8_SA(1, 1), a1 + hstep, voffA);
            PG8_WAIT_L(8); PG8_BAR; PG8_WAIT_L(0); PG8_MMA(0, 0, At, B0); PG8_BAR; PG8_SCHED;
            PG8_LDB(B1, 0, 1); PG8_STAGE(PG8_SB(0, 0), b2, voffB);
            PG8_BAR; PG8_WAIT_L(0); PG8_MMA(0, 1, At, B1); PG8_BAR;
            PG8_LDA(At, 0, 1); PG8_STAGE(PG8_SA(0, 0), a2, voffA);
            PG8_BAR; PG8_WAIT_L(0); PG8_MMA(1, 0, At, B0); PG8_BAR; PG8_SCHED;
            PG8_STAGE(PG8_SB(0, 1), b2 + hstep, voffB);
            PG8_WAIT_V(6); PG8_BAR; PG8_MMA(1, 1, At, B1); PG8_BAR;
            PG8_LDB(B0, 1, 0); PG8_SCHED; PG8_LDA(At, 1, 0); PG8_STAGE(PG8_SA(0, 1), a2 + hstep, voffA);
            PG8_WAIT_L(8); PG8_BAR; PG8_WAIT_L(0); PG8_MMA(0, 0, At, B0); PG8_BAR; PG8_SCHED;
            PG8_LDB(B1, 1, 1); PG8_STAGE(PG8_SB(1, 0), b3, voffB);
            PG8_BAR; PG8_WAIT_L(0); PG8_MMA(0, 1, At, B1); PG8_BAR;
            PG8_LDA(At, 1, 1); PG8_STAGE(PG8_SA(1, 0), a3, voffA);
            PG8_BAR; PG8_WAIT_L(0); PG8_MMA(1, 0, At, B0); PG8_BAR; PG8_SCHED;
            PG8_STAGE(PG8_SB(1, 1), b3 + hstep, voffB);
            PG8_WAIT_V(6); PG8_BAR; PG8_MMA(1, 1, At, B1); PG8_BAR;
            }
        }
        if constexpr (ALIGN_EPI) { if (wr == 0) PG8_BAR; }
        if constexpr (!Epi::AFTER_DRAIN) { E(acc, cur, wr, wc, fr, fq); S.done(cur); }
        if (!has_next) break;
#pragma unroll
        for (int a = 0; a < 2; ++a)
#pragma unroll
            for (int b = 0; b < 2; ++b)
#pragma unroll
                for (int m = 0; m < 4; ++m)
#pragma unroll
                    for (int n = 0; n < 2; ++n) acc[a][b][m][n] = (f32x4){0.f, 0.f, 0.f, 0.f};
        cur = nxt; cA = nA; cB = nB; ++ui;
        if constexpr (ALIGN_EPI) { if (wr == 1) PG8_BAR; }
    }
    PG8_WAIT_V(0);
    if constexpr (!ALIGN_EPI) { if (wr == 0) PG8_BAR; }
    PG8_BAR;
    if constexpr (Epi::AFTER_DRAIN) { E.fused(acc, cur, wr, wc, fr, fq, lds, wid, lane); S.done(cur); }
#undef PG8_SA
#undef PG8_SB
#undef PG8_STAGE
#undef PG8_LDA
#undef PG8_LDB
#undef PG8_MMA
#undef PG8_WAIT_V
#undef PG8_WAIT_L
#undef PG8_BAR
#undef PG8_SCHED
}
}

#define LAS __attribute__((address_space(3)))
typedef unsigned short bf16;
typedef float f32x4 __attribute__((ext_vector_type(4)));
typedef float f32x16 __attribute__((ext_vector_type(16)));
typedef short bf16x8 __attribute__((ext_vector_type(8)));
typedef short s16x4 __attribute__((ext_vector_type(4)));
typedef unsigned u32x4 __attribute__((ext_vector_type(4)));
typedef unsigned u32x2 __attribute__((ext_vector_type(2)));
constexpr int NB = 8, S = 4096, D = 1024, M = NB * S, FF = 2816, NIN = 2560, NMOD = 9216;
constexpr float EPS = 1e-6f, LOG2E = 1.4426950408889634f;
constexpr size_t MiB = 1u << 20;
constexpr size_t WS_MOD = 0, WS_CA = 1 * MiB, WS_CH = 2 * MiB, WS_WRG = 3 * MiB, WS_BAR = 4 * MiB, WS_QCTR = 4 * MiB + 64 * 1024, WS_SW = 4 * MiB + 512 * 1024;
constexpr size_t WS_WUP1 = 8 * MiB, WS_WDN1 = 19 * MiB, WS_WUP2 = 25 * MiB, WS_WDN2 = 36 * MiB, WS_WIN = 42 * MiB, WS_WOUT = 47 * MiB;
constexpr size_t WS_HBUF = 50 * MiB, WS_MIX = 114 * MiB, WS_X1 = 178 * MiB, WS_R1 = 306 * MiB, WS_SSQ = 482 * MiB, WS_END = 488 * MiB;
constexpr int LDS_BYTES = 147456;
constexpr int NWAVES = 8;

struct Args { const float* in[24]; float* out; unsigned char* ws; int ph_lo, ph_hi; };

__device__ __forceinline__ float wave_sum(float v) {
#pragma unroll
    for (int o = 1; o < 64; o <<= 1) v += __shfl_xor(v, o);
    return v;
}
__device__ __forceinline__ float bf2f(unsigned short h) { return __uint_as_float((unsigned)h << 16); }
using pg8::pk_bf16; using pg8::sigmoid_f;

__device__ __forceinline__ void transpose_item(const float* W, int K, int N, bf16* WT, int k0, int n0, int drow0, LAS float* scr, int lane) {
    float tv[32];
#pragma unroll
    for (int i = 0; i < 32; ++i) { const int kk = 2 * i + (lane >> 5); tv[i] = W[(size_t)(k0 + kk) * N + n0 + (lane & 31)]; }
#pragma unroll
    for (int i = 0; i < 32; ++i) { const int kk = 2 * i + (lane >> 5); scr[kk * 33 + (lane & 31)] = tv[i]; }
    asm volatile("s_waitcnt lgkmcnt(0)" ::: "memory");
    const int c = lane & 7;
#pragma unroll
    for (int j = 0; j < 4; ++j) { const int n = (lane >> 3) + 8 * j; const LAS float* s = scr + (8 * c) * 33 + n;
        u32x4 o; o.x = pk_bf16(s[0 * 33], s[1 * 33]); o.y = pk_bf16(s[2 * 33], s[3 * 33]); o.z = pk_bf16(s[4 * 33], s[5 * 33]); o.w = pk_bf16(s[6 * 33], s[7 * 33]);
        *(u32x4*)(WT + (size_t)(drow0 + n) * K + k0 + 8 * c) = o; }
    asm volatile("s_waitcnt lgkmcnt(0)" ::: "memory");
}
__device__ __forceinline__ void p0_prologue(const Args& a, LAS unsigned char* lds, int tid, int lane, int wave, int G) {
    unsigned char* ws = a.ws;
    LAS float* scr = (LAS float*)(lds + wave * 8448);
    const int gw = blockIdx.x * NWAVES + wave, NGW = G * NWAVES;
    constexpr int I_FF = (D / 64) * (FF / 32);
    constexpr int I_IN = (D / 64) * (NIN / 32);
    constexpr int I_OUT = (D / 64) * (D / 32);
    constexpr int NITEMS = 6 * I_FF + I_IN + I_OUT;
    for (int it = gw; it < NITEMS; it += NGW) {
        int r = it;
        if (r < 6 * I_FF) {
            const int f = r / (3 * I_FF); r -= f * 3 * I_FF; const int which = r / I_FF; r -= which * I_FF;
            const float* W = a.in[(f ? 21 : 5) + which];
            if (which < 2) { const int nblk = FF / 32, kb = r / nblk, nb = r % nblk, n0 = 32 * nb;
                transpose_item(W, D, FF, (bf16*)(ws + (f ? WS_WUP2 : WS_WUP1)), 64 * kb, n0, 256 * (n0 >> 7) + 128 * which + (n0 & 127), scr, lane); }
            else { const int nblk = D / 32, kb = r / nblk, nb = r % nblk, n0 = 32 * nb;
                transpose_item(W, FF, D, (bf16*)(ws + (f ? WS_WDN2 : WS_WDN1)), 64 * kb, n0, n0, scr, lane); }
            continue;
        }
        r -= 6 * I_FF;
        if (r < I_IN) { const int nblk = NIN / 32, kb = r / nblk, nb = r % nblk, n0 = 32 * nb;
            const int pn = n0 >> 8, rr = n0 & 255, wc = rr >> 6, bj = (rr >> 5) & 1;
            transpose_item(a.in[8], D, NIN, (bf16*)(ws + WS_WIN), 64 * kb, n0, 256 * pn + 128 * bj + 32 * wc, scr, lane); continue; }
        r -= I_IN;
        { const int nblk = D / 32, kb = r / nblk, nb = r % nblk, n0 = 32 * nb;
          transpose_item(a.in[20], D, D, (bf16*)(ws + WS_WOUT), 64 * kb, n0, n0, scr, lane); }
    }
    { bf16* wrg = (bf16*)(ws + WS_WRG);
      for (int e = blockIdx.x * 512 + tid; e < 2 * 8 * 64 * 64; e += G * 512) { const int g = e >> 15, n = (e >> 12) & 7, co = (e >> 6) & 63, ci = e & 63;
          const float v = a.in[g ? 17 : 15][(n * 64 + ci) * 64 + co]; wrg[e] = (bf16)(pk_bf16(v, 0.f) & 0xffffu); } }
    { LAS float* cact = (LAS float*)(lds + 73728);
      LAS float* red = (LAS float*)(lds + 110592);
      __syncthreads();
      for (int e = tid; e < NB * D; e += 512) { const float v = a.in[1][e]; cact[e] = v * sigmoid_f(v); }
      __syncthreads();
      float* mod = (float*)(ws + WS_MOD);
      for (int cb = blockIdx.x; cb < NMOD / 36; cb += G) {
          if (tid < 504) { const int kg = tid / 36, col = tid % 36, j = 36 * cb + col; float accb[NB];
#pragma unroll
              for (int b = 0; b < NB; ++b) accb[b] = 0.f;
              for (int k0 = kg; k0 < D; k0 += 14 * 8) { float w[8];
#pragma unroll
                  for (int u = 0; u < 8; ++u) { const int k = k0 + 14 * u; w[u] = (k < D) ? a.in[2][(size_t)k * NMOD + j] : 0.f; }
#pragma unroll
                  for (int u = 0; u < 8; ++u) { const int k = (k0 + 14 * u < D) ? k0 + 14 * u : 0;
#pragma unroll
                      for (int b = 0; b < NB; ++b) accb[b] += cact[b * D + k] * w[u]; } }
#pragma unroll
              for (int b = 0; b < NB; ++b) red[(kg * NB + b) * 36 + col] = accb[b]; }
          __syncthreads();
          if (tid < NB * 36) { const int b = tid / 36, col = tid % 36, j = 36 * cb + col; float s = a.in[3][j];
              for (int kg = 0; kg < 14; ++kg) s += red[(kg * NB + b) * 36 + col];
              mod[b * NMOD + j] = s; }
          __syncthreads();
      } }
}

__device__ __forceinline__ void p1_phase(const float* src, bf16* dst, float* ssq, const float* gnorm, const float* mod, const bf16* Wup1, const bf16* Win, const bf16* Wup2, float* sW, int lane, int wave, int G) {
    const int gw = blockIdx.x * NWAVES + wave, NGW = G * NWAVES;
    for (int rb = gw; rb < M / 16; rb += NGW) {
        const int b = rb >> 8;
        f32x4 gs[4];
#pragma unroll
        for (int j = 0; j < 4; ++j) { const int col = 4 * lane + 256 * j; gs[j] = *(const f32x4*)(gnorm + col) * (*(const f32x4*)(mod + (size_t)b * NMOD + 1024 + col) + 1.0f); }
#pragma unroll 1
        for (int r8 = 0; r8 < 16; r8 += 8) {
            f32x4 v[8][4];
#pragma unroll
            for (int q = 0; q < 8; ++q)
#pragma unroll
                for (int j = 0; j < 4; ++j) v[q][j] = *((const f32x4*)(src + ((size_t)rb * 16 + r8 + q) * D) + lane + 64 * j);
            float ssv[8];
#pragma unroll
            for (int q = 0; q < 8; ++q) { const size_t row = (size_t)rb * 16 + r8 + q; float ss = 0.f;
                u32x2* o8 = (u32x2*)(dst + row * D) + lane;
#pragma unroll
                for (int j = 0; j < 4; ++j) { const f32x4 x = v[q][j]; ss += (x.x * x.x + x.y * x.y) + (x.z * x.z + x.w * x.w); const f32x4 o = x * gs[j]; u32x2 w; w.x = pk_bf16(o.x, o.y); w.y = pk_bf16(o.z, o.w); o8[64 * j] = w; }
                ssv[q] = ss; }
#pragma unroll
            for (int o_ = 1; o_ < 64; o_ <<= 1) {
#pragma unroll
                for (int q = 0; q < 8; ++q) ssv[q] += __shfl_xor(ssv[q], o_); }
#pragma unroll
            for (int q = 0; q < 8; ++q) { const size_t row = (size_t)rb * 16 + r8 + q; if (lane < 16) ssq[row * 16 + lane] = (lane == 0) ? ssv[q] : 0.f; }
        }
    }
#pragma unroll 1
    for (int seg = 0; seg < 3; ++seg) {
        const int nrows = (seg == 1) ? 2560 : 5632;
        const bf16* Wt = (seg == 0) ? Wup1 : (seg == 1) ? Win : Wup2;
        float* o = sW + ((seg == 0) ? 0 : (seg == 1) ? 8 * 5632 : 8 * 5632 + 8 * 2560);
        const float* sh = mod + seg * 3072;
        if (gw >= nrows) continue;
        f32x4 shv[NB][4];
#pragma unroll
        for (int b = 0; b < NB; ++b)
#pragma unroll
            for (int q = 0; q < 4; ++q) shv[b][q] = *(const f32x4*)(sh + (size_t)b * NMOD + 16 * lane + 4 * q);
        for (int R = gw; R < nrows; R += NGW) {
            const bf16* wrow = Wt + (size_t)R * D;
            const u32x4 w0 = *(const u32x4*)(wrow + 16 * lane), w1 = *(const u32x4*)(wrow + 16 * lane + 8);
            float wf[16];
#pragma unroll
            for (int e = 0; e < 4; ++e) { wf[2 * e] = __uint_as_float(w0[e] << 16); wf[2 * e + 1] = __uint_as_float(w0[e] & 0xffff0000u); wf[8 + 2 * e] = __uint_as_float(w1[e] << 16); wf[8 + 2 * e + 1] = __uint_as_float(w1[e] & 0xffff0000u); }
            float sv[NB];
#pragma unroll
            for (int b = 0; b < NB; ++b) { float s_ = 0.f;
#pragma unroll
                for (int q = 0; q < 4; ++q) { const f32x4 t = shv[b][q]; s_ += t.x * wf[4 * q] + t.y * wf[4 * q + 1] + t.z * wf[4 * q + 2] + t.w * wf[4 * q + 3]; }
                sv[b] = s_; }
#pragma unroll
            for (int o_ = 1; o_ < 64; o_ <<= 1) {
#pragma unroll
                for (int b = 0; b < NB; ++b) sv[b] += __shfl_xor(sv[b], o_); }
#pragma unroll
            for (int b = 0; b < NB; ++b) { if (lane == b) o[(size_t)b * nrows + R] = sv[b]; }
        }
    }
}

__device__ __forceinline__ float one_minus_exp(float y, float a_) {
    const float p = -y * (1.0f + y * (0.5f + y * (0.16666667f + y * (0.041666668f + y * (0.0083333338f + y * 0.0013888889f)))));
    const float q = 1.0f - a_ * a_;
    return (y > -0.25f) ? p : q;
}
constexpr int SC_XT = 0, SC_GT = 5056, SC_OT = 9664, SC_WAVE = 14272, SC_P = 144;
__device__ __forceinline__ void scan_pass1(int b, int c, int n, const bf16* proj, const bf16* wrg, const float* convw, const float* convb, const float* ba, const float* bx,
                                           const float* lru, float* cA, float* cH, bf16* mixin, bf16* gpb, LAS unsigned char* wl, int lane) {
    const int r32 = lane & 31, hi = lane >> 5;
    const int rowbase = b * S, t0 = c * 64;
    const char* pj = (const char*)proj; const char* wr = (const char*)wrg; const char* cw = (const char*)convw;
    float p_ba[2], p_bx[2], p_c[2], p_w[2][4], p_cb[2], cur[2], aprod[2];
#pragma unroll
    for (int ct = 0; ct < 2; ++ct) { const int ch = 64 * n + 32 * ct + r32;
        p_ba[ct] = ba[ch]; p_bx[ct] = bx[ch]; p_c[ct] = -8.0f * log1pf(expf(-lru[ch])); p_cb[ct] = convb[ch];
#pragma unroll
        for (int i = 0; i < 4; ++i) p_w[ct][i] = convw[i * 512 + ch];
        cur[ct] = 0.f; aprod[ct] = 1.f; }
    u32x4 xraw[5], graw[4];
#define SC_LOADS(tt_) do { \
        _Pragma("unroll") for (int j = 0; j < 5; ++j) { const int pid = lane + 64 * j, row = pid >> 3, pc = pid & 7; const int trow = t0 + 32 * (tt_) - 3 + row; const int trc = trow < 0 ? 0 : trow; \
            u32x4 v = (u32x4){0u, 0u, 0u, 0u}; if (pid < 280) v = *(const u32x4*)(pj + ((unsigned)(rowbase + trc) * NIN + 2048u + 64u * n + 8u * pc) * 2u); if (trow < 0) v = (u32x4){0u, 0u, 0u, 0u}; xraw[j] = v; } \
        _Pragma("unroll") for (int j = 0; j < 4; ++j) { const int pid = lane + 64 * j, row = pid >> 3, pc = pid & 7; \
            graw[j] = *(const u32x4*)(pj + ((unsigned)(rowbase + t0 + 32 * (tt_) + row) * NIN + 1536u + 64u * n + 8u * pc) * 2u); } } while (0)
#pragma nounroll
    for (int tt = 0; tt < 2; ++tt) {
        asm volatile("" ::: "memory");
        SC_LOADS(tt);
#pragma unroll
        for (int j = 0; j < 5; ++j) { const int pid = lane + 64 * j, row = pid >> 3, pc = pid & 7; if (pid < 280) *(LAS u32x4*)(wl + SC_XT + row * SC_P + pc * 16) = xraw[j]; }
#pragma unroll
        for (int j = 0; j < 4; ++j) { const int pid = lane + 64 * j, row = pid >> 3, pc = pid & 7; *(LAS u32x4*)(wl + SC_GT + row * SC_P + pc * 16) = graw[j]; }
        asm volatile("" ::: "memory");
        float xrv[2][16];
#pragma unroll
        for (int ct = 0; ct < 2; ++ct) {
            const int chl = 32 * ct + r32;
#pragma unroll
            for (int sg = 0; sg < 4; ++sg) {
                float xv[7];
#pragma unroll
                for (int i = 0; i < 7; ++i) xv[i] = bf2f(*(const LAS bf16*)(wl + SC_XT + (8 * sg + 4 * hi + i) * SC_P + chl * 2));
#pragma unroll
                for (int e = 0; e < 4; ++e) {
                    const float xr = p_cb[ct] + p_w[ct][0] * xv[e] + p_w[ct][1] * xv[e + 1] + p_w[ct][2] * xv[e + 2] + p_w[ct][3] * xv[e + 3];
                    xrv[ct][4 * sg + e] = xr;
                    *(LAS bf16*)(wl + SC_OT + (8 * sg + 4 * hi + e) * SC_P + chl * 2) = (bf16)(pk_bf16(xr, 0.f) & 0xffffu);
                }
            }
        }
        asm volatile("" ::: "memory");
        bf16x8 af[4];
#pragma unroll
        for (int ks = 0; ks < 4; ++ks) af[ks] = *(const LAS bf16x8*)(wl + SC_OT + r32 * SC_P + (16 * ks + 8 * hi) * 2);
        asm volatile("" ::: "memory");
#pragma unroll
        for (int ct = 0; ct < 2; ++ct) {
            const int chl = 32 * ct + r32;
            f32x16 dA = f32x16{}, dX = f32x16{};
#pragma unroll
            for (int ks = 0; ks < 4; ++ks) {
                const unsigned wo = (unsigned)(((n * 64 + chl) * 64) + 16 * ks + 8 * hi) * 2u;
                const bf16x8 wa = *(const bf16x8*)(wr + wo);
                const bf16x8 wx = *(const bf16x8*)(wr + wo + 65536u);
                dA = __builtin_amdgcn_mfma_f32_32x32x16_bf16(af[ks], wa, dA, 0, 0, 0);
                dX = __builtin_amdgcn_mfma_f32_32x32x16_bf16(af[ks], wx, dX, 0, 0, 0);
            }
            float hl[16], P[16], As[4], Hs[4];
#pragma unroll
            for (int sg = 0; sg < 4; ++sg) {
                float hrun = 0.f, prun = 1.f;
#pragma unroll
                for (int e = 0; e < 4; ++e) {
                    const int ri = 4 * sg + e;
                    const float xr = xrv[ct][ri];
                    const float rg = sigmoid_f(dA[ri] + p_ba[ct]), ig = sigmoid_f(dX[ri] + p_bx[ct]);
                    const float la = p_c[ct] * rg, av = __builtin_amdgcn_exp2f(la * LOG2E);
                    const float uv = __builtin_amdgcn_sqrtf(one_minus_exp(2.0f * la, av)) * (ig * xr);
                    hrun = av * hrun + uv; prun *= av; hl[ri] = hrun; P[ri] = prun;
                }
                As[sg] = prun; Hs[sg] = hrun;
            }
            float cin[4], pin[4]; float cr = cur[ct], ap_ = aprod[ct];
#pragma unroll
            for (int sg = 0; sg < 4; ++sg) {
                const float Ao = __shfl_xor(As[sg], 32), Ho = __shfl_xor(Hs[sg], 32);
                const float Alo = hi ? Ao : As[sg], Hlo = hi ? Ho : Hs[sg], Ahi = hi ? As[sg] : Ao, Hhi = hi ? Hs[sg] : Ho;
                const float clo = cr, chi = Alo * clo + Hlo; cr = Ahi * chi + Hhi; cin[sg] = hi ? chi : clo;
                const float plo = ap_, phi = plo * Alo; ap_ = phi * Ahi; pin[sg] = hi ? phi : plo;
            }
            cur[ct] = cr; aprod[ct] = ap_;
#pragma unroll
            for (int sg = 0; sg < 4; ++sg)
#pragma unroll
                for (int e = 0; e < 4; ++e) { const int ri = 4 * sg + e; const int lo_ = (8 * sg + 4 * hi + e) * SC_P + chl * 2;
                    const float h = hl[ri] + P[ri] * cin[sg], pc_ = P[ri] * pin[sg];
                    const float gt = bf2f(*(const LAS bf16*)(wl + SC_GT + lo_));
                    const float z = 0.7978845608f * (gt + 0.044715f * gt * gt * gt);
                    const float ge = gt * __builtin_amdgcn_rcpf(1.0f + __builtin_amdgcn_exp2f(z * (-2.0f * LOG2E)));
                    *(LAS bf16*)(wl + SC_GT + lo_) = (bf16)(pk_bf16(ge * h, 0.f) & 0xffffu);
                    *(LAS bf16*)(wl + SC_OT + lo_) = (bf16)(pk_bf16(ge * pc_, 0.f) & 0xffffu); }
            asm volatile("" ::: "memory");
        }
        asm volatile("" ::: "memory");
#pragma unroll
        for (int j = 0; j < 4; ++j) { const int pid = lane + 64 * j, row = pid >> 3, pc = pid & 7; const unsigned grow = (unsigned)(rowbase + t0 + 32 * tt + row);
            const u32x4 v1 = *(const LAS u32x4*)(wl + SC_GT + row * SC_P + pc * 16), v2 = *(const LAS u32x4*)(wl + SC_OT + row * SC_P + pc * 16);
            *(u32x4*)((char*)mixin + (grow * D + 512u + 64u * n + 8u * pc) * 2u) = v1;
            *(u32x4*)((char*)gpb + (grow * 512u + 64u * n + 8u * pc) * 2u) = v2; }
        asm volatile("" ::: "memory");
    }
#undef SC_LOADS
    if (hi == 0) {
#pragma unroll
        for (int ct = 0; ct < 2; ++ct) { const size_t o = ((size_t)(b * 64 + c)) * 512 + 64 * n + 32 * ct + r32; cA[o] = aprod[ct]; cH[o] = cur[ct]; } }
}
__device__ __forceinline__ void scan_fix(int u, const float* cA, const float* cH, bf16* mixin, const bf16* gpb, int lane) {
    const int b = u >> 8, c = (u >> 2) & 63, q4 = u & 3;
    if (c == 0) return;
    float cr[8];
#pragma unroll
    for (int e = 0; e < 8; ++e) cr[e] = 0.f;
#pragma unroll 4
    for (int j = 0; j < c; ++j) { const unsigned o = (unsigned)((b * 64 + j) * 512 + 8 * lane) * 4u;
        const f32x4 a0 = *(const f32x4*)((const char*)cA + o), a1 = *(const f32x4*)((const char*)cA + o + 16), h0 = *(const f32x4*)((const char*)cH + o), h1 = *(const f32x4*)((const char*)cH + o + 16);
        cr[0] = a0.x * cr[0] + h0.x; cr[1] = a0.y * cr[1] + h0.y; cr[2] = a0.z * cr[2] + h0.z; cr[3] = a0.w * cr[3] + h0.w;
        cr[4] = a1.x * cr[4] + h1.x; cr[5] = a1.y * cr[5] + h1.y; cr[6] = a1.z * cr[6] + h1.z; cr[7] = a1.w * cr[7] + h1.w; }
#pragma unroll 4
    for (int r = 0; r < 16; ++r) { const unsigned row = (unsigned)(b * S + c * 64 + q4 * 16 + r);
        char* mp = (char*)mixin + (row * D + 512u + 8u * lane) * 2u;
        const u32x4 o1 = *(const u32x4*)mp, g = *(const u32x4*)((const char*)gpb + (row * 512u + 8u * lane) * 2u);
        u32x4 w;
#pragma unroll
        for (int e = 0; e < 4; ++e) { const float lo_ = __uint_as_float(o1[e] << 16) + __uint_as_float(g[e] << 16) * cr[2 * e], hi_ = __uint_as_float(o1[e] & 0xffff0000u) + __uint_as_float(g[e] & 0xffff0000u) * cr[2 * e + 1]; w[e] = pk_bf16(lo_, hi_); }
        *(u32x4*)mp = w; }
}

namespace att {
typedef LAS const char* lds_cptr;
typedef short v4i16_t __attribute__((ext_vector_type(4)));
constexpr int SLOT = 16384, LDS_K = 0, LDS_V = 2 * SLOT, LDS_X = 4 * SLOT;
__device__ __forceinline__ int crow(int r, int hi) { return (r & 3) + 8 * (r >> 2) + 4 * hi; }
__device__ __forceinline__ void glds16(const void* gsrc, unsigned lds_dst) { unsigned keep;
    asm volatile("s_mov_b32 %0, m0\n\ts_mov_b32 m0, %2\n\ts_nop 0\n\tglobal_load_lds_dwordx4 %1, off\n\ts_mov_b32 m0, %0" : "=&s"(keep) : "v"(gsrc), "s"(lds_dst) : "memory"); }
__device__ __forceinline__ s16x4 vtr(lds_cptr p) { return __builtin_bit_cast(s16x4, __builtin_amdgcn_ds_read_tr16_b64_v4i16((LAS v4i16_t*)p)); }
__device__ __forceinline__ float fadd_s(float a_, float b_) { float r_; asm("v_add_f32_e32 %0, %1, %2" : "=v"(r_) : "v"(a_), "v"(b_)); return r_; }
__device__ __forceinline__ float swap_max(float m) { auto rr = __builtin_amdgcn_permlane32_swap(__float_as_uint(m), __float_as_uint(m), false, false); return __builtin_fmaxf(__uint_as_float(rr[0]), __uint_as_float(rr[1])); }
__device__ __forceinline__ float swap_sum(float m) { auto rr = __builtin_amdgcn_permlane32_swap(__float_as_uint(m), __float_as_uint(m), false, false); return __uint_as_float(rr[0]) + __uint_as_float(rr[1]); }

__device__ __forceinline__ void attn_unit(int b, int h, int qb, int kt_min, const bf16* proj, bf16* mixin, char* shm, float lam, const float* hng) {
    int tid_l = threadIdx.x; asm volatile("" : "+v"(tid_l));
    const int tid = tid_l, lane = tid & 63, r32 = lane & 31, hi = lane >> 5; const int wid = __builtin_amdgcn_readfirstlane(tid >> 6);
    const int qg = wid & 3, mp = wid >> 2;
    const size_t rowbase = (size_t)b * S; const int q0 = qb * 128;
    const float slope2 = __builtin_amdgcn_exp2f(-2.0f * (float)(h + 1)) * LOG2E;
    const unsigned lds0 = (unsigned)(uintptr_t)shm; const lds_cptr shm3 = (lds_cptr)shm;
    const bf16* ksrc = proj + (rowbase + lane) * NIN + 512 + h * 128 + wid * 8;
    const bf16* vsrc = proj + (rowbase + 16 * (wid & 3) + (lane >> 2)) * NIN + 1024 + h * 128 + (wid >> 2) * 32 + (lane & 3) * 8;
    const unsigned kdst = lds0 + LDS_K + wid * 1024, vdst = lds0 + LDS_V + wid * 1024;
#define ATT_DMA(t, slot) do { const size_t go_ = (size_t)(t) * 64 * NIN; \
        glds16(ksrc + go_, (unsigned)__builtin_amdgcn_readfirstlane(kdst + (slot))); glds16(ksrc + go_ + 64, (unsigned)__builtin_amdgcn_readfirstlane(kdst + (slot) + 8192)); \
        glds16(vsrc + go_, (unsigned)__builtin_amdgcn_readfirstlane(vdst + (slot))); glds16(vsrc + go_ + 64, (unsigned)__builtin_amdgcn_readfirstlane(vdst + (slot) + 8192)); } while (0)
    const int NT = 2 * qb + 2, mylast = 2 * qb + (qg >> 1);
    ATT_DMA(NT - 1, 0);
    bf16x8 qr[4];
    { const bf16* Qw = proj + (rowbase + q0 + qg * 32 + r32) * NIN + h * 128 + mp * 64 + hi * 8;
#pragma unroll
      for (int d0 = 0; d0 < 4; ++d0) qr[d0] = *(const bf16x8*)(Qw + d0 * 16); }
    const lds_cptr kp0 = shm3 + LDS_K + mp * 8192 + hi * 1024 + r32 * 16;
    const lds_cptr vp0 = shm3 + LDS_V + ((lane >> 4) & 1) * 32 + (lane & 3) * 8 + (4 * hi + ((lane & 15) >> 2)) * 64;
    float mref = 0.f, lsum = 0.f; f32x16 o[4];
#pragma unroll
    for (int dq = 0; dq < 4; ++dq) o[dq] = f32x16{};
    float cr[16];
#pragma unroll
    for (int r = 0; r < 16; ++r) cr[r] = slope2 * (float)((r & 3) + 8 * (r >> 2));
    const int qpos = q0 + qg * 32 + r32 - 4 * hi;
    const int NTW = NT - kt_min;
    for (int i = 0; i < NTW; ++i) {
        const int kt = NT - 1 - i, sl = (i & 1) * SLOT;
        asm volatile("s_waitcnt vmcnt(0)\n\ts_barrier" ::: "memory");
        if (i + 1 < NTW) ATT_DMA(kt - 1, SLOT - sl);
        if (kt <= mylast) {
            f32x16 p0, p1;
            const float dqf = (float)(qpos - 64 * kt);
            if (kt < mylast) {
                const float lb0 = -slope2 * dqf - mref, lb1 = lb0 + 32.0f * slope2;
#pragma unroll
                for (int r = 0; r < 16; ++r) { p0[r] = cr[r] + lb0; p1[r] = cr[r] + lb1; }
            } else {
#pragma unroll
                for (int r = 0; r < 16; ++r) { const float ko = (float)((r & 3) + 8 * (r >> 2));
                    p0[r] = __builtin_fmaf(-slope2, __builtin_fabsf(dqf - ko), -mref); p1[r] = __builtin_fmaf(-slope2, __builtin_fabsf(dqf - (ko + 32.0f)), -mref); }
            }
            const lds_cptr kp = kp0 + sl;
#pragma unroll
            for (int d0 = 0; d0 < 4; ++d0) {
                const bf16x8 a0 = *(const LAS bf16x8*)(kp + d0 * 2048), a1 = *(const LAS bf16x8*)(kp + d0 * 2048 + 512);
                p0 = __builtin_amdgcn_mfma_f32_32x32x16_bf16(a0, qr[d0], p0, 0, 0, 0);
                p1 = __builtin_amdgcn_mfma_f32_32x32x16_bf16(a1, qr[d0], p1, 0, 0, 0);
            }
#define MX3(a_, b_, c_) __builtin_fmaxf(__builtin_fmaxf((a_), (b_)), (c_))
            float ra = MX3(p0[0], p0[1], p1[0]), rb = MX3(p0[2], p0[3], p1[1]); ra = MX3(ra, p1[2], p1[3]);
#pragma unroll
            for (int r = 4; r < 16; r += 4) { ra = MX3(ra, p0[r], p0[r + 1]); rb = MX3(rb, p0[r + 2], p0[r + 3]); ra = MX3(ra, p1[r], p1[r + 1]); rb = MX3(rb, p1[r + 2], p1[r + 3]); }
#undef MX3
            const float rm = swap_max(__builtin_fmaxf(ra, rb));
            if (__any(rm > 8.0f)) {
                const float dl = __builtin_fmaxf(rm, 0.f), alpha = __builtin_amdgcn_exp2f(-dl);
                mref += dl; lsum *= alpha;
#pragma unroll
                for (int r = 0; r < 16; ++r) { p0[r] -= dl; p1[r] -= dl; }
#pragma unroll
                for (int dq = 0; dq < 4; ++dq)
#pragma unroll
                    for (int r = 0; r < 16; ++r) o[dq][r] *= alpha;
            }
#pragma unroll
            for (int r = 0; r < 16; ++r) { p0[r] = __builtin_amdgcn_exp2f(p0[r]); p1[r] = __builtin_amdgcn_exp2f(p1[r]); }
            { float sa = fadd_s(p0[0], p1[0]), sb = fadd_s(p0[1], p1[1]), sc = fadd_s(p0[2], p1[2]), sd = fadd_s(p0[3], p1[3]);
#pragma unroll
              for (int r = 4; r < 16; r += 4) { sa = fadd_s(sa, fadd_s(p0[r], p1[r])); sb = fadd_s(sb, fadd_s(p0[r + 1], p1[r + 1])); sc = fadd_s(sc, fadd_s(p0[r + 2], p1[r + 2])); sd = fadd_s(sd, fadd_s(p0[r + 3], p1[r + 3])); }
              lsum += fadd_s(fadd_s(sa, sb), fadd_s(sc, sd)); }
            bf16x8 pf[4];
#pragma unroll
            for (int s = 0; s < 2; ++s) {
                u32x4 w0, w1;
                w0.x = pk_bf16(p0[8 * s + 0], p0[8 * s + 1]); w0.y = pk_bf16(p0[8 * s + 2], p0[8 * s + 3]); w0.z = pk_bf16(p0[8 * s + 4], p0[8 * s + 5]); w0.w = pk_bf16(p0[8 * s + 6], p0[8 * s + 7]);
                w1.x = pk_bf16(p1[8 * s + 0], p1[8 * s + 1]); w1.y = pk_bf16(p1[8 * s + 2], p1[8 * s + 3]); w1.z = pk_bf16(p1[8 * s + 4], p1[8 * s + 5]); w1.w = pk_bf16(p1[8 * s + 6], p1[8 * s + 7]);
                pf[s] = __builtin_bit_cast(bf16x8, w0); pf[2 + s] = __builtin_bit_cast(bf16x8, w1);
            }
            const lds_cptr vp = vp0 + sl;
            s16x4 vlo[2][4], vup[2][4];
#pragma unroll
            for (int ks = 0; ks < 4; ++ks) { vlo[0][ks] = vtr(vp + ks * 1024); vup[0][ks] = vtr(vp + ks * 1024 + 512); }
#pragma unroll
            for (int dq = 0; dq < 4; ++dq) {
                if (dq < 3) {
#pragma unroll
                    for (int ks = 0; ks < 4; ++ks) { vlo[(dq + 1) & 1][ks] = vtr(vp + (dq + 1) * 4096 + ks * 1024); vup[(dq + 1) & 1][ks] = vtr(vp + (dq + 1) * 4096 + ks * 1024 + 512); } }
#pragma unroll
                for (int ks = 0; ks < 4; ++ks) {
                    const s16x4 lo = vlo[dq & 1][ks], up = vup[dq & 1][ks];
                    const bf16x8 vf = (bf16x8){lo[0], lo[1], lo[2], lo[3], up[0], up[1], up[2], up[3]};
                    o[dq] = __builtin_amdgcn_mfma_f32_32x32x16_bf16(vf, pf[ks], o[dq], 0, 0, 0);
                }
                __builtin_amdgcn_sched_barrier(0);
            }
        }
    }
#undef ATT_DMA
    const float inv = 1.0f / swap_sum(lsum);
    LAS float* X = (LAS float*)(shm3 + LDS_X + qg * 16384);
    if (mp == 1) { const float sc = inv * lam;
#pragma unroll
        for (int dq = 0; dq < 4; ++dq)
#pragma unroll
            for (int r = 0; r < 16; ++r) X[(32 * dq + crow(r, hi)) * 32 + r32] = o[dq][r] * sc; }
    asm volatile("s_waitcnt lgkmcnt(0)\n\ts_barrier" ::: "memory");
    if (mp == 0) {
        float ss = 0.f;
#pragma unroll
        for (int dq = 0; dq < 4; ++dq)
#pragma unroll
            for (int r = 0; r < 16; ++r) { const float v = o[dq][r] * inv - X[(32 * dq + crow(r, hi)) * 32 + r32]; o[dq][r] = v; ss += v * v; }
        ss = swap_sum(ss);
        const float rstd = __builtin_amdgcn_rsqf(ss * (1.0f / 128.0f) + EPS) * 0.8f;
        asm volatile("s_waitcnt lgkmcnt(0)" ::: "memory");
        LAS unsigned char* stg = (LAS unsigned char*)X;
#pragma unroll
        for (int dq = 0; dq < 4; ++dq)
#pragma unroll
            for (int g4 = 0; g4 < 4; ++g4) { const int dv0 = 32 * dq + 8 * g4 + 4 * hi; const f32x4 gg = *(const f32x4*)(hng + dv0);
                u32x2 w; w.x = pk_bf16(o[dq][4 * g4 + 0] * rstd * gg.x, o[dq][4 * g4 + 1] * rstd * gg.y); w.y = pk_bf16(o[dq][4 * g4 + 2] * rstd * gg.z, o[dq][4 * g4 + 3] * rstd * gg.w);
                *(LAS u32x2*)(stg + r32 * 272 + dv0 * 2) = w; }
        asm volatile("s_waitcnt lgkmcnt(0)" ::: "memory");
        bf16* Ow = mixin + (rowbase + q0 + qg * 32) * D + h * 128;
#pragma unroll
        for (int i = 0; i < 8; ++i) { const int row = i * 4 + (lane >> 4), chn = lane & 15; const u32x4 v = *(const LAS u32x4*)(stg + row * 272 + chn * 16); *(u32x4*)(Ow + (size_t)row * D + chn * 8) = v; }
        asm volatile("s_waitcnt lgkmcnt(0)" ::: "memory");
    }
}
}

#define GAS __attribute__((address_space(1)))
#define XB_TMO      128
#define XB_XCNT(j)  (256  + 64 * (j))
#define XB_XSUB(j)  (1280 + 64 * (j))
#define XB_XGEN(j)  (2304 + 64 * (j))
#define XB_TOP      3328
#define XB_TOPGEN   3392
#define XCD_BAR_WORDS 3456
#define XB_SPIN_CAP (1u << 18)

__device__ __forceinline__ unsigned xb_ld(unsigned* p)              { return __hip_atomic_load(p, __ATOMIC_RELAXED, __HIP_MEMORY_SCOPE_AGENT); }
__device__ __forceinline__ unsigned xb_add(unsigned* p, unsigned v) { return __hip_atomic_fetch_add(p, v, __ATOMIC_RELAXED, __HIP_MEMORY_SCOPE_AGENT); }
__device__ __forceinline__ unsigned xb_xcc_id() { return (unsigned)__builtin_amdgcn_s_getreg((3 << 11) | 20) & 0xFu; }
#define XB_SPIN(cond, bar) do { unsigned _sp = 0; while (cond) { __builtin_amdgcn_s_sleep(1); \
    if ((++_sp & 255u) == 0u) { if (xb_ld(&(bar)[XB_TMO])) break; if (_sp > XB_SPIN_CAP) { atomicAdd(&(bar)[XB_TMO], 1u); break; } } } } while (0)

struct XcdBarrier {
    unsigned* bar; unsigned x;
    volatile LAS unsigned* st;
};

__device__ __forceinline__ XcdBarrier xcd_barrier_post(unsigned* bar, volatile LAS unsigned* st) {
    XcdBarrier b; b.bar = bar; b.x = xb_xcc_id(); b.st = st;
    if (threadIdx.x == 0) (void)xb_add(&bar[XB_XCNT(b.x)], 1u);
    return b;
}
__device__ __forceinline__ void xcd_barrier_complete(unsigned* bar, unsigned x, unsigned& nloc, unsigned& nx) {
    const unsigned G = gridDim.x * gridDim.y * gridDim.z;
    unsigned sum, cnt, mine, sp = 0u;
    for (;;) {
        sum = 0u; cnt = 0u; mine = 0u;
#pragma unroll
        for (unsigned j = 0; j < 16; ++j) { const unsigned c = xb_ld(&bar[XB_XCNT(j)]); sum += c; cnt += (c > 0u) ? 1u : 0u; mine = (j == x) ? c : mine; }
        if (sum == G) break;
        __builtin_amdgcn_s_sleep(1);
        if ((++sp & 255u) == 0u) { if (xb_ld(&bar[XB_TMO])) break; if (sp > XB_SPIN_CAP) { atomicAdd(&bar[XB_TMO], 1u); break; } }
    }
    nloc = mine > 0u ? mine : 1u; nx = cnt > 0u ? cnt : 1u;
}

__device__ __forceinline__ void xcd_barrier(const XcdBarrier& b) {
    asm volatile("s_waitcnt vmcnt(0)" ::: "memory");
    __syncthreads();
    if (threadIdx.x == 0) {
        unsigned* bar = b.bar;
        __builtin_amdgcn_s_waitcnt(0);
        unsigned nloc = b.st[0], nx = b.st[1];
        if (nloc == 0u) { xcd_barrier_complete(bar, b.x, nloc, nx); b.st[0] = nloc; b.st[1] = nx; }
        const unsigned old = xb_add(&bar[XB_XSUB(b.x)], 1u);
        const unsigned gen = old / nloc;
        if (old + 1u == (gen + 1u) * nloc) {
            __builtin_amdgcn_fence(__ATOMIC_RELEASE, "agent");
            asm volatile("s_waitcnt vmcnt(0)" ::: "memory");
            const unsigned og = xb_add(&bar[XB_TOP], 1u);
            const unsigned tg = og / nx;
            if (og + 1u == (tg + 1u) * nx) xb_add(&bar[XB_TOPGEN], 1u);
            else XB_SPIN(xb_ld(&bar[XB_TOPGEN]) == tg, bar);
            __builtin_amdgcn_fence(__ATOMIC_ACQUIRE, "agent");
            xb_add(&bar[XB_XGEN(b.x)], 1u);
            asm volatile("s_waitcnt vmcnt(0)" ::: "memory");
        } else {
            XB_SPIN(xb_ld(&bar[XB_XGEN(b.x)]) == gen, bar);
            __builtin_amdgcn_fence(__ATOMIC_ACQUIRE, "agent");
            asm volatile("s_waitcnt vmcnt(0)" ::: "memory");
        }
    }
    __syncthreads();
}

__global__ void __launch_bounds__(512) fwd_mega(Args a) {
    extern __shared__ __attribute__((aligned(16))) unsigned char lds_raw[];
    cg::grid_group grid = cg::this_grid();
    LAS unsigned char* lds = (LAS unsigned char*)lds_raw;
    const int tid0 = threadIdx.x;
    const int G = gridDim.x;
    unsigned char* ws = a.ws;
    float* mod = (float*)(ws + WS_MOD); float* cA = (float*)(ws + WS_CA); float* cH = (float*)(ws + WS_CH);
    bf16* wrg = (bf16*)(ws + WS_WRG);
    bf16* hbuf = (bf16*)(ws + WS_HBUF); bf16* mixin = (bf16*)(ws + WS_MIX); bf16* x1b = (bf16*)(ws + WS_X1);
    bf16* hid = (bf16*)(ws + WS_R1); bf16* proj = (bf16*)(ws + WS_R1);
    float* ssq0 = (float*)(ws + WS_SSQ); float* ssq1 = ssq0 + (size_t)M * 16; float* ssq2 = ssq1 + (size_t)M * 16; float* sW = (float*)(ws + WS_SW);
    const int lo = a.ph_lo, hi_ph = a.ph_hi;
    unsigned* barw = (unsigned*)(ws + WS_BAR);
    volatile LAS unsigned* bst = (volatile LAS unsigned*)(lds + LDS_BYTES - 16);
    if (tid0 < 4) bst[tid0] = 0u;
    if (blockIdx.x == 0) { for (int i = tid0; i < XCD_BAR_WORDS; i += 512) __hip_atomic_store(barw + i, 0u, __ATOMIC_RELAXED, __HIP_MEMORY_SCOPE_AGENT); }
    unsigned* qctr = (unsigned*)(ws + WS_QCTR);
    if (blockIdx.x == 0 && tid0 < 512) __hip_atomic_store(qctr + tid0, 0u, __ATOMIC_RELAXED, __HIP_MEMORY_SCOPE_AGENT);
    XcdBarrier xbar; xbar.bar = barw; xbar.x = 0; xbar.st = bst;
#ifndef PH_MASK
#define PH_MASK 0xFFF
#endif
#define IN(k) (((PH_MASK >> (k)) & 1) && lo <= (k) && (k) < hi_ph)
#define SEAM(k) do { if (IN(k) && IN((k) + 1)) { if ((k) == 0) { grid.sync(); xbar = xcd_barrier_post(barw, bst); } else xcd_barrier(xbar); } } while (0)
#ifndef REP_MASK
#define REP_MASK 0
#endif
#define REP(k) for (int rep_ = 0; rep_ <= ((REP_MASK >> (k)) & 1); ++rep_)

#define LW() int t_ = threadIdx.x; asm volatile("" : "+v"(t_)); const int tid = t_, lane = t_ & 63, wave = __builtin_amdgcn_readfirstlane(t_ >> 6); (void)tid; (void)lane; (void)wave
    REP(0) if (IN(0)) { if (rep_) grid.sync(); LW(); p0_prologue(a, lds, tid, lane, wave, G); } SEAM(0);
    if ((REP_MASK >> 14) & 1) { for (int q_ = 0; q_ < 10; ++q_) grid.sync(); }
    REP(1) if (IN(1)) { if (rep_) grid.sync(); LW(); p1_phase(a.in[0], hbuf, ssq0, a.in[4], mod, (const bf16*)(ws + WS_WUP1), (const bf16*)(ws + WS_WIN), (const bf16*)(ws + WS_WUP2), sW, lane, wave, G); } SEAM(1);
    REP(2) if (IN(2)) { if (rep_) grid.sync(); pg8::Gemm g{hbuf, (const bf16*)(ws + WS_WUP1), M, 2 * FF, D}; pg8::StaticOrder So; So.init(M, 2 * FF, G, (int)blockIdx.x);
        pg8::EpiSwiglu E{hid, ssq0, sW}; pg8::gemm_phase<pg8::EpiSwiglu, pg8::StaticOrder, true, true>(lds, g, So, E); } SEAM(2);
    REP(3) if (IN(3)) { if (rep_) grid.sync(); pg8::Gemm g{hid, (const bf16*)(ws + WS_WDN1), M, D, FF}; pg8::StaticOrder So; So.init(M, D, G, (int)blockIdx.x);
        pg8::EpiResid<true, true, false, true> E{a.in[0], x1b, mod + 0 * 3072 + 2048, hbuf, ssq1, a.in[4] + 1024, mod + 3072 + 1024}; pg8::gemm_phase<pg8::EpiResid<true, true, false, true>, pg8::StaticOrder, true, true>(lds, g, So, E); } SEAM(3);
    REP(5) if (IN(5)) { if (rep_) grid.sync(); pg8::Gemm g{hbuf, (const bf16*)(ws + WS_WIN), M, NIN, D}; pg8::StaticOrder So; So.init(M, NIN, G, (int)blockIdx.x);
        pg8::EpiWin E{proj, a.in[9], a.in[10], ssq1, sW + 8 * 5632}; pg8::gemm_phase<pg8::EpiWin, pg8::StaticOrder, true, true>(lds, g, So, E); } SEAM(5);
    REP(6) if (IN(6)) { if (rep_) grid.sync(); LW();
        for (int wu = blockIdx.x; wu < NB * 64; wu += G) scan_pass1(wu >> 6, wu & 63, wave, proj, wrg, a.in[13], a.in[14], a.in[16], a.in[18], a.in[19], cA, cH, mixin, hbuf, lds + wave * SC_WAVE, lane);
        asm volatile("s_waitcnt vmcnt(0) lgkmcnt(0)" ::: "memory"); __syncthreads();
        }
    REP(7) if (IN(7)) { if (rep_) grid.sync(); LW();
        float lam;
        { const float* lp = a.in[11]; const float s1 = wave_sum(lp[lane] * lp[64 + lane]), s2 = wave_sum(lp[128 + lane] * lp[192 + lane]); lam = expf(s1) - expf(s2) + 0.2f; }
#ifndef NO_ATT
        float Bs2;
        { const float gqm = __builtin_fmaxf(__builtin_fabsf(a.in[9][lane]), __builtin_fabsf(a.in[9][64 + lane])), gkm = __builtin_fmaxf(__builtin_fabsf(a.in[10][lane]), __builtin_fabsf(a.in[10][64 + lane]));
          float mq = gqm, mk = gkm;
#pragma unroll
          for (int o_ = 1; o_ < 64; o_ <<= 1) { mq = __builtin_fmaxf(mq, __shfl_xor(mq, o_)); mk = __builtin_fmaxf(mk, __shfl_xor(mk, o_)); }
          Bs2 = 16.0f * mq * mk + 25.0f; }
        volatile LAS unsigned* qslot = (volatile LAS unsigned*)(lds + LDS_BYTES - 32);
        bool published = false;
        const int q_home = (int)(xb_xcc_id() & 7u);
        for (int repa_ = 0; repa_ <= ((REP_MASK >> 12) & 1); ++repa_)
        for (int dq_ = 0; dq_ < 8; ++dq_) {
            const int qi = (q_home + dq_) & 7;
            for (;;) {
                if (tid == 0) qslot[0] = atomicAdd(qctr + 64 * qi + 16 * repa_, 1u);
                asm volatile("s_waitcnt vmcnt(0) lgkmcnt(0)\n\ts_barrier" ::: "memory");
                const unsigned uu = qslot[0];
                asm volatile("s_waitcnt lgkmcnt(0)\n\ts_barrier" ::: "memory");
                if (uu >= 128u) break;
                const int qb = 31 - (int)(uu >> 2), h = (int)(uu & 3u);
                const float Wh = Bs2 * __builtin_amdgcn_exp2f(2.0f * (float)(h + 1));
                int ktm = (int)(((float)(qb * 128) - Wh - 0.5f) * (1.0f / 64.0f)); if (ktm < 0) ktm = 0;
                att::attn_unit(qi, h, qb, ktm, proj, mixin, (char*)lds_raw, lam, a.in[12]);
                if (!published) { published = true;
                    asm volatile("s_waitcnt vmcnt(0)" ::: "memory"); __syncthreads();
                    if (tid == 0) { __builtin_amdgcn_fence(__ATOMIC_RELEASE, "agent"); asm volatile("s_waitcnt vmcnt(0)" ::: "memory"); (void)xb_add(qctr + 480, 1u); } }
            }
        }
        if (!published) { asm volatile("s_waitcnt vmcnt(0)" ::: "memory"); __syncthreads();
            if (tid == 0) { __builtin_amdgcn_fence(__ATOMIC_RELEASE, "agent"); asm volatile("s_waitcnt vmcnt(0)" ::: "memory"); (void)xb_add(qctr + 480, 1u); } }
#endif
#ifndef NO_SCANF
        const int gw = blockIdx.x * NWAVES + wave, NGW = G * NWAVES;
        if (tid == 0) { unsigned sp_ = 0;
            while (xb_ld(qctr + 480) < (unsigned)G) { __builtin_amdgcn_s_sleep(1); if (++sp_ > (1u << 22)) break; }
            __builtin_amdgcn_fence(__ATOMIC_ACQUIRE, "agent"); asm volatile("s_waitcnt vmcnt(0)" ::: "memory"); }
        __syncthreads();
        for (int reps_ = 0; reps_ <= ((REP_MASK >> 13) & 1); ++reps_)
        for (int u = gw; u < 2048; u += NGW) scan_fix(u, cA, cH, mixin, hbuf, lane);
#endif
        asm volatile("s_waitcnt vmcnt(0) lgkmcnt(0)" ::: "memory"); __syncthreads();
    } SEAM(7);
    REP(8) if (IN(8)) { if (rep_) grid.sync(); pg8::Gemm g{mixin, (const bf16*)(ws + WS_WOUT), M, D, D}; pg8::StaticOrder So; So.init(M, D, G, (int)blockIdx.x);
        pg8::EpiResid<true, false, true, true> E{x1b, x1b, mod + 1 * 3072 + 2048, hbuf, ssq2, a.in[4] + 2048, mod + 6144 + 1024}; pg8::gemm_phase<pg8::EpiResid<true, false, true, true>, pg8::StaticOrder, true, true>(lds, g, So, E); } SEAM(8);
    REP(10) if (IN(10)) { if (rep_) grid.sync(); pg8::Gemm g{hbuf, (const bf16*)(ws + WS_WUP2), M, 2 * FF, D}; pg8::StaticOrder So; So.init(M, 2 * FF, G, (int)blockIdx.x);
        pg8::EpiSwiglu E{hid, ssq2, sW + 8 * 5632 + 8 * 2560}; pg8::gemm_phase<pg8::EpiSwiglu, pg8::StaticOrder, true, true>(lds, g, So, E); } SEAM(10);
    REP(11) if (IN(11)) { if (rep_) grid.sync(); pg8::Gemm g{hid, (const bf16*)(ws + WS_WDN2), M, D, FF}; pg8::StaticOrder So; So.init(M, D, G, (int)blockIdx.x);
        pg8::EpiResid<false, true, true, false> E{x1b, a.out, mod + 2 * 3072 + 2048, nullptr, nullptr, nullptr, nullptr}; pg8::gemm_phase<pg8::EpiResid<false, true, true, false>, pg8::StaticOrder, true, true>(lds, g, So, E); }
#undef IN
#undef SEAM
}

extern "C" void kernel_launch(void* const* d_in, const int* in_sizes, int n_in, void* d_out, int out_size, void* d_ws, size_t ws_size, hipStream_t stream) {
    static int grid = 0;
    if (grid == 0) {
        if (n_in != 24 || in_sizes[0] != M * D || out_size != M * D || ws_size < WS_END) { fprintf(stderr, "kernel_launch: unexpected shapes (n_in %d, in0 %d, out %d, ws %zu); nothing launched\n", n_in, n_in > 0 ? in_sizes[0] : -1, out_size, ws_size); grid = -1; return; }
        int dev = 0, cus = 0, per_cu = 0;
        if (hipGetDevice(&dev) != hipSuccess || hipDeviceGetAttribute(&cus, hipDeviceAttributeMultiprocessorCount, dev) != hipSuccess) { grid = -1; return; }
        if (hipFuncSetAttribute((const void*)fwd_mega, hipFuncAttributeMaxDynamicSharedMemorySize, LDS_BYTES) != hipSuccess) { fprintf(stderr, "kernel_launch: hipFuncSetAttribute failed\n"); grid = -1; return; }
        if (hipOccupancyMaxActiveBlocksPerMultiprocessor(&per_cu, (const void*)fwd_mega, NWAVES * 64, LDS_BYTES) != hipSuccess || per_cu < 1) { fprintf(stderr, "kernel_launch: occupancy query says %d blocks per CU\n", per_cu); (void)hipGetLastError(); grid = -1; return; }
        grid = cus * per_cu;
        if (grid > 256) grid = 256;
    }
    if (grid < 0) return;
    Args a{};
    for (int i = 0; i < 24; ++i) a.in[i] = (const float*)d_in[i];
    a.out = (float*)d_out; a.ws = (unsigned char*)d_ws; a.ph_lo = 0; a.ph_hi = 12;
    void* kargs[] = {&a};
    hipError_t e = hipLaunchCooperativeKernel((const void*)fwd_mega, dim3(grid), dim3(NWAVES * 64), kargs, LDS_BYTES, stream);
    if (e != hipSuccess) fprintf(stderr, "kernel_launch: cooperative launch failed: %s (grid %d)\n", hipGetErrorString(e), grid);
}
```

```cpp
#include <hip/hip_runtime.h>
#include <hip/hip_cooperative_groups.h>
#include <cstdio>
#include <cstdint>
namespace cg = cooperative_groups;
namespace pg8 {
#define PG8_LAS __attribute__((address_space(3)))
typedef unsigned short bf16_t;
typedef short bf16x8 __attribute__((ext_vector_type(8)));
typedef float f32x4 __attribute__((ext_vector_type(4)));
typedef unsigned u32x4 __attribute__((ext_vector_type(4)));
constexpr int BM = 256, BK = 64, HALF = 128, HTB = HALF * BK * 2  , STAGE_BYTES = 8 * HTB, NXCD = 8, WGM = 8;

__host__ __device__ __forceinline__ int lds_byte(int r, int c) { const int st = (r >> 4) * 2 + (c >> 5), rr = r & 15, cc = c & 31, ob = rr * 64 + cc * 2; return st * 1024 + (ob ^ (((ob >> 9) & 1) << 5)); }
__host__ __device__ __forceinline__ void stage_rc(int b, int& R, int& C) { const int st = b / 1024, sb = b % 1024, swz = sb ^ (((sb >> 9) & 1) << 5); R = (st >> 1) * 16 + swz / 64; C = (st & 1) * 32 + (swz % 64) / 2; }
__host__ __device__ __forceinline__ int perm32(int rho) { const int n = rho >> 4, i = rho & 15; return 8 * (i >> 2) + 4 * n + (i & 3); }

struct Unit { int pm, pn; };
struct Gemm { const bf16_t* A; const bf16_t* Bt; int M, N, K; };

struct StaticOrder {
    int nM, nN, nwg, G, c;
    __host__ __device__ void init(int M, int N, int G_, int c_) { nM = M / BM; nN = N / BM; nwg = nM * nN; G = G_; c = c_; }
    __host__ __device__ bool next(int i, Unit& u) const {
        const long L = (long)i * G + c; if (L >= nwg) return false;
        int wgid = (int)L; { const int q = nwg / NXCD, r = nwg % NXCD, xcd = wgid % NXCD, off = wgid / NXCD; wgid = (xcd < r ? xcd * (q + 1) : r * (q + 1) + (xcd - r) * q) + off; }
        const int nig = WGM * nN, gid = wgid / nig, fm = gid * WGM, gsz = (nM - fm) < WGM ? (nM - fm) : WGM;
        u.pm = fm + ((wgid % nig) % gsz); u.pn = (wgid % nig) / gsz; return true;
    }
    __device__ __forceinline__ void a_ready(const Unit&) const {}
    __device__ __forceinline__ void done(const Unit&) const {}
};


typedef unsigned u32x2 __attribute__((ext_vector_type(2)));
typedef float f32x2_t __attribute__((ext_vector_type(2))); typedef __bf16 bf16x2_t __attribute__((ext_vector_type(2)));
__device__ __forceinline__ unsigned pk_bf16(float lo, float hi) { f32x2_t v = {lo, hi}; bf16x2_t b = __builtin_convertvector(v, bf16x2_t); return __builtin_bit_cast(unsigned, b); }
__device__ __forceinline__ float sigmoid_f(float v) { return __builtin_amdgcn_rcpf(1.0f + __builtin_amdgcn_exp2f(v * -1.4426950408889634f)); }

__device__ __forceinline__ float row_rstd(const float* ssq, int row, int fq) {
    const f32x4 q = *(const f32x4*)(ssq + (size_t)row * 16 + 4 * fq);
    float s = (q[0] + q[1]) + (q[2] + q[3]); s += __shfl_xor(s, 16); s += __shfl_xor(s, 32);
    return __builtin_amdgcn_rsqf(s * (1.0f / 1024.0f) + 1e-6f);
}
__device__ __forceinline__ void row_rstd8(const float* ssq, int row0, int fq, float (&rs)[2][4]) {
    f32x4 q[2][4];
#pragma unroll
    for (int ai = 0; ai < 2; ++ai)
#pragma unroll
        for (int m = 0; m < 4; ++m) q[ai][m] = *(const f32x4*)(ssq + (size_t)(row0 + ai * HALF + m * 16) * 16 + 4 * fq);
#pragma unroll
    for (int ai = 0; ai < 2; ++ai)
#pragma unroll
        for (int m = 0; m < 4; ++m) { float s = (q[ai][m][0] + q[ai][m][1]) + (q[ai][m][2] + q[ai][m][3]); s += __shfl_xor(s, 16); s += __shfl_xor(s, 32); rs[ai][m] = __builtin_amdgcn_rsqf(s * (1.0f / 1024.0f) + 1e-6f); }
}
struct EpiSwiglu {
    static constexpr bool PERM = true, AFTER_DRAIN = false;
    bf16_t* O; const float* ssq; const float* sW;
    __device__ __forceinline__ void operator()(const f32x4 (&acc)[2][2][4][2], const Unit& u, int wr, int wc, int fr, int fq) const {
        const int row0 = u.pm * BM + wr * 64 + fr, col0 = u.pn * 128 + wc * 32 + 8 * fq, b = u.pm >> 4;
        const float* sw = sW + (size_t)b * 5632 + u.pn * BM + wc * 32 + 8 * fq;
        const f32x4 sg0 = *(const f32x4*)(sw), sg1 = *(const f32x4*)(sw + 4), su0 = *(const f32x4*)(sw + HALF), su1 = *(const f32x4*)(sw + HALF + 4);
        const f32x4 ng0 = sg0 * -1.4426950408889634f, ng1 = sg1 * -1.4426950408889634f;
        float rsv[2][4]; row_rstd8(ssq, row0, fq, rsv);
#pragma unroll
        for (int ai = 0; ai < 2; ++ai)
#pragma unroll
            for (int m = 0; m < 4; ++m) {
                const int row = row0 + ai * HALF + m * 16;
                const float rs = rsv[ai][m];
                bf16_t* rowp = O + (size_t)row * 2816 + col0;
                const f32x4 g0 = acc[ai][0][m][0] * rs + sg0, g1 = acc[ai][0][m][1] * rs + sg1, u0 = acc[ai][1][m][0] * rs + su0, u1 = acc[ai][1][m][1] * rs + su1;
                const float nrs = rs * -1.4426950408889634f;
                const f32x4 t0 = acc[ai][0][m][0] * nrs + ng0, t1 = acc[ai][0][m][1] * nrs + ng1;
                float h[8];
#pragma unroll
                for (int e = 0; e < 4; ++e) { h[e] = g0[e] * __builtin_amdgcn_rcpf(1.0f + __builtin_amdgcn_exp2f(t0[e])) * u0[e]; h[4 + e] = g1[e] * __builtin_amdgcn_rcpf(1.0f + __builtin_amdgcn_exp2f(t1[e])) * u1[e]; }
                u32x4 w; w.x = pk_bf16(h[0], h[1]); w.y = pk_bf16(h[2], h[3]); w.z = pk_bf16(h[4], h[5]); w.w = pk_bf16(h[6], h[7]);
                __builtin_nontemporal_store(w, (u32x4*)rowp);
            }
    }
};
template <bool NORM, bool HALFC, bool RES16, bool OUT16> struct EpiResid {
    static constexpr bool PERM = true, AFTER_DRAIN = false;
    const void* res; void* out; const float* gate;
    bf16_t* An; float* ssq; const float* gn; const float* scl;
    __device__ __forceinline__ void operator()(const f32x4 (&acc)[2][2][4][2], const Unit& u, int wr, int wc, int fr, int fq) const {
        const int row0 = u.pm * BM + wr * 64 + fr, col0 = u.pn * BM + wc * 32 + 8 * fq, b = u.pm >> 4;
        f32x4 gv[2][2], gs[2][2];
#pragma unroll
        for (int bj = 0; bj < 2; ++bj)
#pragma unroll
            for (int n = 0; n < 2; ++n) { gv[bj][n] = *(const f32x4*)(gate + (size_t)b * 9216 + col0 + bj * HALF + n * 4) * (HALFC ? 0.5f : 1.0f);
                if (NORM) gs[bj][n] = *(const f32x4*)(gn + col0 + bj * HALF + n * 4) * (*(const f32x4*)(scl + (size_t)b * 9216 + col0 + bj * HALF + n * 4) + 1.0f); }
        constexpr int GR = RES16 ? 4 : 2;
#pragma unroll
        for (int am = 0; am < 8 / GR; ++am) {
            const int ai = (am * GR) >> 2, m0 = (am * GR) & 3;
            f32x4 rr[RES16 ? 1 : GR][2][2]; u32x4 rw[RES16 ? GR : 1][2];
#pragma unroll
            for (int mm = 0; mm < GR; ++mm)
#pragma unroll
                for (int bj = 0; bj < 2; ++bj) { const size_t off = (size_t)(row0 + ai * HALF + (m0 + mm) * 16) * 1024 + col0 + bj * HALF;
                    if (RES16) rw[mm][bj] = *(const u32x4*)((const bf16_t*)res + off);
                    else { rr[mm][bj][0] = __builtin_nontemporal_load((const f32x4*)((const float*)res + off)); rr[mm][bj][1] = __builtin_nontemporal_load((const f32x4*)((const float*)res + off + 4)); } }
#pragma unroll
            for (int mm = 0; mm < GR; ++mm) {
                const int m = m0 + mm;
                const int row = row0 + ai * HALF + m * 16;
                const size_t off = (size_t)row * 1024 + col0;
                float ss = 0.f;
#pragma unroll
                for (int bj = 0; bj < 2; ++bj) {
                    f32x4 r0, r1;
                    if (RES16) { const u32x4 w = rw[mm][bj];
                        r0 = (f32x4){__uint_as_float(w.x << 16), __uint_as_float(w.x & 0xffff0000u), __uint_as_float(w.y << 16), __uint_as_float(w.y & 0xffff0000u)};
                        r1 = (f32x4){__uint_as_float(w.z << 16), __uint_as_float(w.z & 0xffff0000u), __uint_as_float(w.w << 16), __uint_as_float(w.w & 0xffff0000u)}; }
                    else { r0 = rr[mm][bj][0]; r1 = rr[mm][bj][1]; }
                    const f32x4 o0 = r0 + gv[bj][0] * acc[ai][bj][m][0], o1 = r1 + gv[bj][1] * acc[ai][bj][m][1];
                    if (OUT16) { u32x4 w; w.x = pk_bf16(o0[0], o0[1]); w.y = pk_bf16(o0[2], o0[3]); w.z = pk_bf16(o1[0], o1[1]); w.w = pk_bf16(o1[2], o1[3]); *(u32x4*)((bf16_t*)out + off + bj * HALF) = w; }
                    else { __builtin_nontemporal_store(o0, (f32x4*)((float*)out + off + bj * HALF)); __builtin_nontemporal_store(o1, (f32x4*)((float*)out + off + bj * HALF + 4)); }
                    if (NORM) { ss += ((o0[0] * o0[0] + o0[1] * o0[1]) + (o0[2] * o0[2] + o0[3] * o0[3])) + ((o1[0] * o1[0] + o1[1] * o1[1]) + (o1[2] * o1[2] + o1[3] * o1[3]));
                        const f32x4 a0 = o0 * gs[bj][0], a1 = o1 * gs[bj][1];
                        u32x4 w; w.x = pk_bf16(a0[0], a0[1]); w.y = pk_bf16(a0[2], a0[3]); w.z = pk_bf16(a1[0], a1[1]); w.w = pk_bf16(a1[2], a1[3]);
                        *(u32x4*)(An + off + bj * HALF) = w; } }
                if (NORM) { ss += __shfl_xor(ss, 16); ss += __shfl_xor(ss, 32); if (fq == 0) ssq[(size_t)row * 16 + 4 * u.pn + wc] = ss; }
            }
            asm volatile("" ::: "memory");
        }
    }
};
struct EpiWin {
    static constexpr bool PERM = true, AFTER_DRAIN = false;
    bf16_t* O; const float* gq; const float* gk; const float* ssq; const float* sW;
    __device__ __forceinline__ void operator()(const f32x4 (&acc)[2][2][4][2], const Unit& u, int wr, int wc, int fr, int fq) const {
        const int row0 = u.pm * BM + wr * 64 + fr, col0 = u.pn * BM + wc * 64 + 8 * fq;
        const float* sw = sW + (size_t)(u.pm >> 4) * 2560 + u.pn * BM + wc * 32 + 8 * fq;
        f32x4 sb[2][2];
#pragma unroll
        for (int bj = 0; bj < 2; ++bj)
#pragma unroll
            for (int n = 0; n < 2; ++n) sb[bj][n] = *(const f32x4*)(sw + bj * HALF + 4 * n);
        float rsv[2][4]; row_rstd8(ssq, row0, fq, rsv);
        if (u.pn < 4) {
            const float* g = (u.pn < 2 ? gq : gk) + (wc & 1) * 64 + 8 * fq;
            const float sc = (u.pn < 2) ? 0.125f * 1.4426950408889634f : 1.0f;
            f32x4 gv[2][2];
#pragma unroll
            for (int bj = 0; bj < 2; ++bj)
#pragma unroll
                for (int n = 0; n < 2; ++n) gv[bj][n] = *(const f32x4*)(g + 32 * bj + 4 * n) * sc;
#pragma unroll
            for (int ai = 0; ai < 2; ++ai)
#pragma unroll
                for (int m = 0; m < 4; ++m) {
                    const float rs = rsv[ai][m];
                    f32x4 xv[2][2];
                    float ss = 0.f;
#pragma unroll
                    for (int bj = 0; bj < 2; ++bj)
#pragma unroll
                        for (int n = 0; n < 2; ++n) { const f32x4 x = acc[ai][bj][m][n] * rs + sb[bj][n]; xv[bj][n] = x; ss += (x[0] * x[0] + x[1] * x[1]) + (x[2] * x[2] + x[3] * x[3]); }
                    ss += __shfl_xor(ss, 16); ss += __shfl_xor(ss, 32);
                    const float rstd = __builtin_amdgcn_rsqf(ss * (1.0f / 64.0f) + 1e-6f);
                    bf16_t* rowp = O + (size_t)(row0 + ai * HALF + m * 16) * 2560 + col0;
#pragma unroll
                    for (int bj = 0; bj < 2; ++bj) { const f32x4 v0 = xv[bj][0] * rstd * gv[bj][0], v1 = xv[bj][1] * rstd * gv[bj][1];
                        u32x4 w; w.x = pk_bf16(v0[0], v0[1]); w.y = pk_bf16(v0[2], v0[3]); w.z = pk_bf16(v1[0], v1[1]); w.w = pk_bf16(v1[2], v1[3]);
                        *(u32x4*)(rowp + 32 * bj) = w; }
                }
        } else {
#pragma unroll
            for (int ai = 0; ai < 2; ++ai)
#pragma unroll
                for (int m = 0; m < 4; ++m) {
                    const float rs = rsv[ai][m];
                    bf16_t* rowp = O + (size_t)(row0 + ai * HALF + m * 16) * 2560 + col0;
#pragma unroll
                    for (int bj = 0; bj < 2; ++bj) { const f32x4 v0 = acc[ai][bj][m][0] * rs + sb[bj][0], v1 = acc[ai][bj][m][1] * rs + sb[bj][1];
                        u32x4 w; w.x = pk_bf16(v0[0], v0[1]); w.y = pk_bf16(v0[2], v0[3]); w.z = pk_bf16(v1[0], v1[1]); w.w = pk_bf16(v1[2], v1[3]);
                        *(u32x4*)(rowp + 32 * bj) = w; }
                }
        }
    }
};

template <class Epi, class Sched, bool ALIGN_EPI = false, bool SP2 = false>
__device__ __forceinline__ void gemm_phase(PG8_LAS unsigned char* lds, const Gemm g, const Sched& S, const Epi& E) {
    int tid_l = threadIdx.x; asm volatile("" : "+v"(tid_l));
    const int tid = tid_l, wid = __builtin_amdgcn_readfirstlane(tid >> 6), lane = tid & 63, wr = wid >> 2, wc = wid & 3, fr = lane & 15, fq = lane >> 4;
    const int K = g.K, nt = K / BK;
    unsigned voffA[2], voffB[2];
#pragma unroll
    for (int i = 0; i < 2; ++i) { int R, C; stage_rc(tid * 16 + i * 8192, R, C); const int Rb = Epi::PERM ? ((R & ~31) + perm32(R & 31)) : R;
        voffA[i] = (unsigned)(R * K + C) * 2u; voffB[i] = (unsigned)(Rb * K + C) * 2u; }
    const size_t kstep = (size_t)(BK * 2);
    const size_t hstep = (size_t)HALF * K * 2;
    const size_t tstep = 2 * hstep;
    const unsigned ldsw = (unsigned)wid * 1024u;
    const int aoff = lds_byte(wr * 64 + fr, fq * 8), boff = lds_byte(wc * 32 + fr, fq * 8);
#define PG8_SA(b, h) (((b) * 2 + (h)) * HTB)
#define PG8_SB(b, h) ((4 + (b) * 2 + (h)) * HTB)
#define PG8_STAGE(bufoff, gbase, voff) do { _Pragma("unroll") for (int _i = 0; _i < 2; ++_i) \
        __builtin_amdgcn_global_load_lds((const unsigned*)((const char*)(gbase) + (voff)[_i]), (PG8_LAS unsigned*)(lds + (bufoff) + ldsw + _i * 8192), 16, 0, 0); } while (0)
#define PG8_LDA(dst, b, h) do { _Pragma("unroll") for (int m = 0; m < 4; ++m) _Pragma("unroll") for (int k = 0; k < 2; ++k) dst[m][k] = *(const PG8_LAS bf16x8*)(lds + PG8_SA(b, h) + aoff + m * 2048 + k * 1024); } while (0)
#define PG8_LDB(dst, b, h) do { _Pragma("unroll") for (int n = 0; n < 2; ++n) _Pragma("unroll") for (int k = 0; k < 2; ++k) dst[n][k] = *(const PG8_LAS bf16x8*)(lds + PG8_SB(b, h) + boff + n * 2048 + k * 1024); } while (0)
#define PG8_MMA(ai, bj, At, Bt) do { __builtin_amdgcn_s_setprio(1); _Pragma("unroll") for (int m = 0; m < 4; ++m) _Pragma("unroll") for (int n = 0; n < 2; ++n) _Pragma("unroll") for (int k = 0; k < 2; ++k) \
        acc[ai][bj][m][n] = __builtin_amdgcn_mfma_f32_16x16x32_bf16(Bt[n][k], At[m][k], acc[ai][bj][m][n], 0, 0, 0); __builtin_amdgcn_s_setprio(0); } while (0)
#define PG8_WAIT_V(n) asm volatile("s_waitcnt vmcnt(" #n ")" ::: "memory")
#define PG8_WAIT_L(n) asm volatile("s_waitcnt lgkmcnt(" #n ")" ::: "memory")
#define PG8_BAR __builtin_amdgcn_s_barrier()
#define PG8_SCHED __builtin_amdgcn_sched_barrier(0)
    Unit cur, nxt; int ui = 0;
    if (!S.next(0, cur)) return;
    f32x4 acc[2][2][4][2];
#pragma unroll
    for (int a = 0; a < 2; ++a)
#pragma unroll
        for (int b = 0; b < 2; ++b)
#pragma unroll
            for (int m = 0; m < 4; ++m)
#pragma unroll
                for (int n = 0; n < 2; ++n) acc[a][b][m][n] = (f32x4){0.f, 0.f, 0.f, 0.f};
    bf16x8 At[4][2], B0[2][2], B1[2][2];
    const char* cA = (const char*)g.A + (size_t)cur.pm * tstep; const char* cB = (const char*)g.Bt + (size_t)cur.pn * tstep;
    S.a_ready(cur);
    if constexpr (SP2) {
        PG8_STAGE(PG8_SB(0, 0), cB, voffB); PG8_STAGE(PG8_SB(0, 1), cB + hstep, voffB); PG8_STAGE(PG8_SA(0, 0), cA, voffA); PG8_STAGE(PG8_SA(0, 1), cA + hstep, voffA);
        if (wr == 1) PG8_BAR;
        PG8_WAIT_V(2); PG8_BAR;
        PG8_STAGE(PG8_SB(1, 0), cB + kstep, voffB); PG8_STAGE(PG8_SA(1, 0), cA + kstep, voffA); PG8_STAGE(PG8_SB(1, 1), cB + hstep + kstep, voffB);
        PG8_WAIT_V(6); PG8_BAR;
    } else {
        PG8_STAGE(PG8_SB(0, 0), cB, voffB); PG8_STAGE(PG8_SA(0, 0), cA, voffA); PG8_STAGE(PG8_SB(0, 1), cB + hstep, voffB); PG8_STAGE(PG8_SA(0, 1), cA + hstep, voffA);
        if (wr == 1) PG8_BAR;
        PG8_WAIT_V(4); PG8_BAR;
        PG8_STAGE(PG8_SB(1, 0), cB + kstep, voffB); PG8_STAGE(PG8_SA(1, 0), cA + kstep, voffA); PG8_STAGE(PG8_SB(1, 1), cB + hstep + kstep, voffB);
        PG8_WAIT_V(6); PG8_BAR;
    }
    for (;;) {
        const bool has_next = S.next(ui + 1, nxt);
        const char* nA = has_next ? (const char*)g.A + (size_t)nxt.pm * tstep : cA; const char* nB = has_next ? (const char*)g.Bt + (size_t)nxt.pn * tstep : cB;
        for (int t = 0; t < nt; t += 2) {
            const bool last = (t == nt - 2);
            const char* a1 = cA + (size_t)(t + 1) * kstep;
            const char* a2 = last ? nA : cA + (size_t)(t + 2) * kstep; const char* b2 = last ? nB : cB + (size_t)(t + 2) * kstep;
            const char* a3 = a2 + kstep; const char* b3 = b2 + kstep;
            if (last && has_next) S.a_ready(nxt);
            if constexpr (SP2) {
            PG8_LDB(B0, 0, 0); PG8_LDB(B1, 0, 1); PG8_SCHED; PG8_LDA(At, 0, 0); PG8_STAGE(PG8_SA(1, 1), a1 + hstep, voffA);
            PG8_WAIT_V(8); PG8_WAIT_L(0); PG8_BAR; PG8_MMA(0, 0, At, B0); PG8_MMA(0, 1, At, B1); PG8_BAR; PG8_SCHED;
            PG8_LDA(At, 0, 1); PG8_STAGE(PG8_SB(0, 0), b2, voffB); PG8_STAGE(PG8_SB(0, 1), b2 + hstep, voffB); PG8_STAGE(PG8_SA(0, 0), a2, voffA);
            PG8_WAIT_V(8); PG8_WAIT_L(0); PG8_BAR; PG8_MMA(1, 0, At, B0); PG8_MMA(1, 1, At, B1); PG8_BAR; PG8_SCHED;
            PG8_LDB(B0, 1, 0); PG8_LDB(B1, 1, 1); PG8_SCHED; PG8_LDA(At, 1, 0); PG8_STAGE(PG8_SA(0, 1), a2 + hstep, voffA);
            PG8_WAIT_V(8); PG8_WAIT_L(0); PG8_BAR; PG8_MMA(0, 0, At, B0); PG8_MMA(0, 1, At, B1); PG8_BAR; PG8_SCHED;
            PG8_LDA(At, 1, 1); PG8_STAGE(PG8_SB(1, 0), b3, voffB); PG8_STAGE(PG8_SB(1, 1), b3 + hstep, voffB); PG8_STAGE(PG8_SA(1, 0), a3, voffA);
            PG8_WAIT_V(8); PG8_WAIT_L(0); PG8_BAR; PG8_MMA(1, 0, At, B0); PG8_MMA(1, 1, At, B1); PG8_BAR; PG8_SCHED;
            } else {
            PG8_LDB(B0, 0, 0); PG8_SCHED; PG8_LDA(At, 0, 0); PG8_STAGE(PG8_SA(1, 1), a1 + hstep, voffA);
            PG8_WAIT_L(8); PG8_BAR; PG8_WAIT_L(0); PG8_MMA(0, 0, At, B0); PG8_BAR; PG8_SCHED;
            PG8_LDB(B1, 0, 1); PG8_STAGE(PG8_SB(0, 0), b2, voffB);
            PG8_BAR; PG8_WAIT_L(0); PG8_MMA(0, 1, At, B1); PG8_BAR;
            PG8_LDA(At, 0, 1); PG8_STAGE(PG8_SA(0, 0), a2, voffA);
            PG8_BAR; PG8_WAIT_L(0); PG8_MMA(1, 0, At, B0); PG8_BAR; PG8_SCHED;
            PG8_STAGE(PG8_SB(0, 1), b2 + hstep, voffB);
            PG8_WAIT_V(6); PG8_BAR; PG8_MMA(1, 1, At, B1); PG8_BAR;
            PG8_LDB(B0, 1, 0); PG8_SCHED; PG8_LDA(At, 1, 0); PG8_STAGE(PG8_SA(0, 1), a2 + hstep, voffA);
            PG8_WAIT_L(8); PG8_BAR; PG8_WAIT_L(0); PG8_MMA(0, 0, At, B0); PG8_BAR; PG8_SCHED;
            PG8_LDB(B1, 1, 1); PG8_STAGE(PG8_SB(1, 0), b3, voffB);
            PG8_BAR; PG8_WAIT_L(0); PG8_MMA(0, 1, At, B1); PG8_BAR;
            PG8_LDA(At, 1, 1); PG8_STAGE(PG8_SA(1, 0), a3, voffA);
            PG8_BAR; PG8_WAIT_L(0); PG8_MMA(1, 0, At, B0); PG8_BAR; PG8_SCHED;
            PG8_STAGE(PG8_SB(1, 1), b3 + hstep, voffB);
            PG8_WAIT_V(6); PG8_BAR; PG8_MMA(1, 1, At, B1); PG8_BAR;
            }
        }
        if constexpr (ALIGN_EPI) { if (wr == 0) PG8_BAR; }
        if constexpr (!Epi::AFTER_DRAIN) { E(acc, cur, wr, wc, fr, fq); S.done(cur); }
        if (!has_next) break;
#pragma unroll
        for (int a = 0; a < 2; ++a)
#pragma unroll
            for (int b = 0; b < 2; ++b)
#pragma unroll
                for (int m = 0; m < 4; ++m)
#pragma unroll
                    for (int n = 0; n < 2; ++n) acc[a][b][m][n] = (f32x4){0.f, 0.f, 0.f, 0.f};
        cur = nxt; cA = nA; cB = nB; ++ui;
        if constexpr (ALIGN_EPI) { if (wr == 1) PG8_BAR; }
    }
    PG8_WAIT_V(0);
    if constexpr (!ALIGN_EPI) { if (wr == 0) PG8_BAR; }
    PG8_BAR;
    if constexpr (Epi::AFTER_DRAIN) { E.fused(acc, cur, wr, wc, fr, fq, lds, wid, lane); S.done(cur); }
#undef PG8_SA
#undef PG8_SB
#undef PG8_STAGE
#undef PG8_LDA
#undef PG8_LDB
#undef PG8_MMA
#undef PG8_WAIT_V
#undef PG8_WAIT_L
#undef PG8_BAR
#undef PG8_SCHED
}
}

#define LAS __attribute__((address_space(3)))
typedef unsigned short bf16;
typedef float f32x4 __attribute__((ext_vector_type(4)));
typedef float f32x16 __attribute__((ext_vector_type(16)));
typedef short bf16x8 __attribute__((ext_vector_type(8)));
typedef short s16x4 __attribute__((ext_vector_type(4)));
typedef unsigned u32x4 __attribute__((ext_vector_type(4)));
typedef unsigned u32x2 __attribute__((ext_vector_type(2)));
constexpr int NB = 8, S = 4096, D = 1024, M = NB * S, FF = 2816, NIN = 2560, NMOD = 9216;
constexpr float EPS = 1e-6f, LOG2E = 1.4426950408889634f;
constexpr size_t MiB = 1u << 20;
constexpr size_t WS_MOD = 0, WS_CA = 1 * MiB, WS_CH = 2 * MiB, WS_WRG = 3 * MiB, WS_BAR = 4 * MiB, WS_QCTR = 4 * MiB + 64 * 1024, WS_SW = 4 * MiB + 512 * 1024;
constexpr size_t WS_WUP1 = 8 * MiB, WS_WDN1 = 19 * MiB, WS_WUP2 = 25 * MiB, WS_WDN2 = 36 * MiB, WS_WIN = 42 * MiB, WS_WOUT = 47 * MiB;
constexpr size_t WS_HBUF = 50 * MiB, WS_MIX = 114 * MiB, WS_X1 = 178 * MiB, WS_R1 = 306 * MiB, WS_SSQ = 482 * MiB, WS_END = 488 * MiB;
constexpr int LDS_BYTES = 147456;
constexpr int NWAVES = 8;

struct Args { const float* in[24]; float* out; unsigned char* ws; int ph_lo, ph_hi; };

__device__ __forceinline__ float wave_sum(float v) {
#pragma unroll
    for (int o = 1; o < 64; o <<= 1) v += __shfl_xor(v, o);
    return v;
}
__device__ __forceinline__ float bf2f(unsigned short h) { return __uint_as_float((unsigned)h << 16); }
using pg8::pk_bf16; using pg8::sigmoid_f;

__device__ __forceinline__ void transpose_item(const float* W, int K, int N, bf16* WT, int k0, int n0, int drow0, LAS float* scr, int lane) {
    float tv[32];
#pragma unroll
    for (int i = 0; i < 32; ++i) { const int kk = 2 * i + (lane >> 5); tv[i] = W[(size_t)(k0 + kk) * N + n0 + (lane & 31)]; }
#pragma unroll
    for (int i = 0; i < 32; ++i) { const int kk = 2 * i + (lane >> 5); scr[kk * 33 + (lane & 31)] = tv[i]; }
    asm volatile("s_waitcnt lgkmcnt(0)" ::: "memory");
    const int c = lane & 7;
#pragma unroll
    for (int j = 0; j < 4; ++j) { const int n = (lane >> 3) + 8 * j; const LAS float* s = scr + (8 * c) * 33 + n;
        u32x4 o; o.x = pk_bf16(s[0 * 33], s[1 * 33]); o.y = pk_bf16(s[2 * 33], s[3 * 33]); o.z = pk_bf16(s[4 * 33], s[5 * 33]); o.w = pk_bf16(s[6 * 33], s[7 * 33]);
        *(u32x4*)(WT + (size_t)(drow0 + n) * K + k0 + 8 * c) = o; }
    asm volatile("s_waitcnt lgkmcnt(0)" ::: "memory");
}
__device__ __forceinline__ void p0_prologue(const Args& a, LAS unsigned char* lds, int tid, int lane, int wave, int G) {
    unsigned char* ws = a.ws;
    LAS float* scr = (LAS float*)(lds + wave * 8448);
    const int gw = blockIdx.x * NWAVES + wave, NGW = G * NWAVES;
    constexpr int I_FF = (D / 64) * (FF / 32);
    constexpr int I_IN = (D / 64) * (NIN / 32);
    constexpr int I_OUT = (D / 64) * (D / 32);
    constexpr int NITEMS = 6 * I_FF + I_IN + I_OUT;
    for (int it = gw; it < NITEMS; it += NGW) {
        int r = it;
        if (r < 6 * I_FF) {
            const int f = r / (3 * I_FF); r -= f * 3 * I_FF; const int which = r / I_FF; r -= which * I_FF;
            const float* W = a.in[(f ? 21 : 5) + which];
            if (which < 2) { const int nblk = FF / 32, kb = r / nblk, nb = r % nblk, n0 = 32 * nb;
                transpose_item(W, D, FF, (bf16*)(ws + (f ? WS_WUP2 : WS_WUP1)), 64 * kb, n0, 256 * (n0 >> 7) + 128 * which + (n0 & 127), scr, lane); }
            else { const int nblk = D / 32, kb = r / nblk, nb = r % nblk, n0 = 32 * nb;
                transpose_item(W, FF, D, (bf16*)(ws + (f ? WS_WDN2 : WS_WDN1)), 64 * kb, n0, n0, scr, lane); }
            continue;
        }
        r -= 6 * I_FF;
        if (r < I_IN) { const int nblk = NIN / 32, kb = r / nblk, nb = r % nblk, n0 = 32 * nb;
            const int pn = n0 >> 8, rr = n0 & 255, wc = rr >> 6, bj = (rr >> 5) & 1;
            transpose_item(a.in[8], D, NIN, (bf16*)(ws + WS_WIN), 64 * kb, n0, 256 * pn + 128 * bj + 32 * wc, scr, lane); continue; }
        r -= I_IN;
        { const int nblk = D / 32, kb = r / nblk, nb = r % nblk, n0 = 32 * nb;
          transpose_item(a.in[20], D, D, (bf16*)(ws + WS_WOUT), 64 * kb, n0, n0, scr, lane); }
    }
    { bf16* wrg = (bf16*)(ws + WS_WRG);
      for (int e = blockIdx.x * 512 + tid; e < 2 * 8 * 64 * 64; e += G * 512) { const int g = e >> 15, n = (e >> 12) & 7, co = (e >> 6) & 63, ci = e & 63;
          const float v = a.in[g ? 17 : 15][(n * 64 + ci) * 64 + co]; wrg[e] = (bf16)(pk_bf16(v, 0.f) & 0xffffu); } }
    { LAS float* cact = (LAS float*)(lds + 73728);
      LAS float* red = (LAS float*)(lds + 110592);
      __syncthreads();
      for (int e = tid; e < NB * D; e += 512) { const float v = a.in[1][e]; cact[e] = v * sigmoid_f(v); }
      __syncthreads();
      float* mod = (float*)(ws + WS_MOD);
      for (int cb = blockIdx.x; cb < NMOD / 36; cb += G) {
          if (tid < 504) { const int kg = tid / 36, col = tid % 36, j = 36 * cb + col; float accb[NB];
#pragma unroll
              for (int b = 0; b < NB; ++b) accb[b] = 0.f;
              for (int k0 = kg; k0 < D; k0 += 14 * 8) { float w[8];
#pragma unroll
                  for (int u = 0; u < 8; ++u) { const int k = k0 + 14 * u; w[u] = (k < D) ? a.in[2][(size_t)k * NMOD + j] : 0.f; }
#pragma unroll
                  for (int u = 0; u < 8; ++u) { const int k = (k0 + 14 * u < D) ? k0 + 14 * u : 0;
#pragma unroll
                      for (int b = 0; b < NB; ++b) accb[b] += cact[b * D + k] * w[u]; } }
#pragma unroll
              for (int b = 0; b < NB; ++b) red[(kg * NB + b) * 36 + col] = accb[b]; }
          __syncthreads();
          if (tid < NB * 36) { const int b = tid / 36, col = tid % 36, j = 36 * cb + col; float s = a.in[3][j];
              for (int kg = 0; kg < 14; ++kg) s += red[(kg * NB + b) * 36 + col];
              mod[b * NMOD + j] = s; }
          __syncthreads();
      } }
}

__device__ __forceinline__ void p1_phase(const float* src, bf16* dst, float* ssq, const float* gnorm, const float* mod, const bf16* Wup1, const bf16* Win, const bf16* Wup2, float* sW, int lane, int wave, int G) {
    const int gw = blockIdx.x * NWAVES + wave, NGW = G * NWAVES;
    for (int rb = gw; rb < M / 16; rb += NGW) {
        const int b = rb >> 8;
        f32x4 gs[4];
#pragma unroll
        for (int j = 0; j < 4; ++j) { const int col = 4 * lane + 256 * j; gs[j] = *(const f32x4*)(gnorm + col) * (*(const f32x4*)(mod + (size_t)b * NMOD + 1024 + col) + 1.0f); }
#pragma unroll 1
        for (int r8 = 0; r8 < 16; r8 += 8) {
            f32x4 v[8][4];
#pragma unroll
            for (int q = 0; q < 8; ++q)
#pragma unroll
                for (int j = 0; j < 4; ++j) v[q][j] = *((const f32x4*)(src + ((size_t)rb * 16 + r8 + q) * D) + lane + 64 * j);
            float ssv[8];
#pragma unroll
            for (int q = 0; q < 8; ++q) { const size_t row = (size_t)rb * 16 + r8 + q; float ss = 0.f;
                u32x2* o8 = (u32x2*)(dst + row * D) + lane;
#pragma unroll
                for (int j = 0; j < 4; ++j) { const f32x4 x = v[q][j]; ss += (x.x * x.x + x.y * x.y) + (x.z * x.z + x.w * x.w); const f32x4 o = x * gs[j]; u32x2 w; w.x = pk_bf16(o.x, o.y); w.y = pk_bf16(o.z, o.w); o8[64 * j] = w; }
                ssv[q] = ss; }
#pragma unroll
            for (int o_ = 1; o_ < 64; o_ <<= 1) {
#pragma unroll
                for (int q = 0; q < 8; ++q) ssv[q] += __shfl_xor(ssv[q], o_); }
#pragma unroll
            for (int q = 0; q < 8; ++q) { const size_t row = (size_t)rb * 16 + r8 + q; if (lane < 16) ssq[row * 16 + lane] = (lane == 0) ? ssv[q] : 0.f; }
        }
    }
#pragma unroll 1
    for (int seg = 0; seg < 3; ++seg) {
        const int nrows = (seg == 1) ? 2560 : 5632;
        const bf16* Wt = (seg == 0) ? Wup1 : (seg == 1) ? Win : Wup2;
        float* o = sW + ((seg == 0) ? 0 : (seg == 1) ? 8 * 5632 : 8 * 5632 + 8 * 2560);
        const float* sh = mod + seg * 3072;
        if (gw >= nrows) continue;
        f32x4 shv[NB][4];
#pragma unroll
        for (int b = 0; b < NB; ++b)
#pragma unroll
            for (int q = 0; q < 4; ++q) shv[b][q] = *(const f32x4*)(sh + (size_t)b * NMOD + 16 * lane + 4 * q);
        for (int R = gw; R < nrows; R += NGW) {
            const bf16* wrow = Wt + (size_t)R * D;
            const u32x4 w0 = *(const u32x4*)(wrow + 16 * lane), w1 = *(const u32x4*)(wrow + 16 * lane + 8);
            float wf[16];
#pragma unroll
            for (int e = 0; e < 4; ++e) { wf[2 * e] = __uint_as_float(w0[e] << 16); wf[2 * e + 1] = __uint_as_float(w0[e] & 0xffff0000u); wf[8 + 2 * e] = __uint_as_float(w1[e] << 16); wf[8 + 2 * e + 1] = __uint_as_float(w1[e] & 0xffff0000u); }
            float sv[NB];
#pragma unroll
            for (int b = 0; b < NB; ++b) { float s_ = 0.f;
#pragma unroll
                for (int q = 0; q < 4; ++q) { const f32x4 t = shv[b][q]; s_ += t.x * wf[4 * q] + t.y * wf[4 * q + 1] + t.z * wf[4 * q + 2] + t.w * wf[4 * q + 3]; }
                sv[b] = s_; }
#pragma unroll
            for (int o_ = 1; o_ < 64; o_ <<= 1) {
#pragma unroll
                for (int b = 0; b < NB; ++b) sv[b] += __shfl_xor(sv[b], o_); }
#pragma unroll
            for (int b = 0; b < NB; ++b) { if (lane == b) o[(size_t)b * nrows + R] = sv[b]; }
        }
    }
}

__device__ __forceinline__ float one_minus_exp(float y, float a_) {
    const float p = -y * (1.0f + y * (0.5f + y * (0.16666667f + y * (0.041666668f + y * (0.0083333338f + y * 0.0013888889f)))));
    const float q = 1.0f - a_ * a_;
    return (y > -0.25f) ? p : q;
}
constexpr int SC_XT = 0, SC_GT = 5056, SC_OT = 9664, SC_WAVE = 14272, SC_P = 144;
__device__ __forceinline__ void scan_pass1(int b, int c, int n, const bf16* proj, const bf16* wrg, const float* convw, const float* convb, const float* ba, const float* bx,
                                           const float* lru, float* cA, float* cH, bf16* mixin, bf16* gpb, LAS unsigned char* wl, int lane) {
    const int r32 = lane & 31, hi = lane >> 5;
    const int rowbase = b * S, t0 = c * 64;
    const char* pj = (const char*)proj; const char* wr = (const char*)wrg; const char* cw = (const char*)convw;
    float p_ba[2], p_bx[2], p_c[2], p_w[2][4], p_cb[2], cur[2], aprod[2];
#pragma unroll
    for (int ct = 0; ct < 2; ++ct) { const int ch = 64 * n + 32 * ct + r32;
        p_ba[ct] = ba[ch]; p_bx[ct] = bx[ch]; p_c[ct] = -8.0f * log1pf(expf(-lru[ch])); p_cb[ct] = convb[ch];
#pragma unroll
        for (int i = 0; i < 4; ++i) p_w[ct][i] = convw[i * 512 + ch];
        cur[ct] = 0.f; aprod[ct] = 1.f; }
    u32x4 xraw[5], graw[4];
#define SC_LOADS(tt_) do { \
        _Pragma("unroll") for (int j = 0; j < 5; ++j) { const int pid = lane + 64 * j, row = pid >> 3, pc = pid & 7; const int trow = t0 + 32 * (tt_) - 3 + row; const int trc = trow < 0 ? 0 : trow; \
            u32x4 v = (u32x4){0u, 0u, 0u, 0u}; if (pid < 280) v = *(const u32x4*)(pj + ((unsigned)(rowbase + trc) * NIN + 2048u + 64u * n + 8u * pc) * 2u); if (trow < 0) v = (u32x4){0u, 0u, 0u, 0u}; xraw[j] = v; } \
        _Pragma("unroll") for (int j = 0; j < 4; ++j) { const int pid = lane + 64 * j, row = pid >> 3, pc = pid & 7; \
            graw[j] = *(const u32x4*)(pj + ((unsigned)(rowbase + t0 + 32 * (tt_) + row) * NIN + 1536u + 64u * n + 8u * pc) * 2u); } } while (0)
#pragma nounroll
    for (int tt = 0; tt < 2; ++tt) {
        asm volatile("" ::: "memory");
        SC_LOADS(tt);
#pragma unroll
        for (int j = 0; j < 5; ++j) { const int pid = lane + 64 * j, row = pid >> 3, pc = pid & 7; if (pid < 280) *(LAS u32x4*)(wl + SC_XT + row * SC_P + pc * 16) = xraw[j]; }
#pragma unroll
        for (int j = 0; j < 4; ++j) { const int pid = lane + 64 * j, row = pid >> 3, pc = pid & 7; *(LAS u32x4*)(wl + SC_GT + row * SC_P + pc * 16) = graw[j]; }
        asm volatile("" ::: "memory");
        float xrv[2][16];
#pragma unroll
        for (int ct = 0; ct < 2; ++ct) {
            const int chl = 32 * ct + r32;
#pragma unroll
            for (int sg = 0; sg < 4; ++sg) {
                float xv[7];
#pragma unroll
                for (int i = 0; i < 7; ++i) xv[i] = bf2f(*(const LAS bf16*)(wl + SC_XT + (8 * sg + 4 * hi + i) * SC_P + chl * 2));
#pragma unroll
                for (int e = 0; e < 4; ++e) {
                    const float xr = p_cb[ct] + p_w[ct][0] * xv[e] + p_w[ct][1] * xv[e + 1] + p_w[ct][2] * xv[e + 2] + p_w[ct][3] * xv[e + 3];
                    xrv[ct][4 * sg + e] = xr;
                    *(LAS bf16*)(wl + SC_OT + (8 * sg + 4 * hi + e) * SC_P + chl * 2) = (bf16)(pk_bf16(xr, 0.f) & 0xffffu);
                }
            }
        }
        asm volatile("" ::: "memory");
        bf16x8 af[4];
#pragma unroll
        for (int ks = 0; ks < 4; ++ks) af[ks] = *(const LAS bf16x8*)(wl + SC_OT + r32 * SC_P + (16 * ks + 8 * hi) * 2);
        asm volatile("" ::: "memory");
#pragma unroll
        for (int ct = 0; ct < 2; ++ct) {
            const int chl = 32 * ct + r32;
            f32x16 dA = f32x16{}, dX = f32x16{};
#pragma unroll
            for (int ks = 0; ks < 4; ++ks) {
                const unsigned wo = (unsigned)(((n * 64 + chl) * 64) + 16 * ks + 8 * hi) * 2u;
                const bf16x8 wa = *(const bf16x8*)(wr + wo);
                const bf16x8 wx = *(const bf16x8*)(wr + wo + 65536u);
                dA = __builtin_amdgcn_mfma_f32_32x32x16_bf16(af[ks], wa, dA, 0, 0, 0);
                dX = __builtin_amdgcn_mfma_f32_32x32x16_bf16(af[ks], wx, dX, 0, 0, 0);
            }
            float hl[16], P[16], As[4], Hs[4];
#pragma unroll
            for (int sg = 0; sg < 4; ++sg) {
                float hrun = 0.f, prun = 1.f;
#pragma unroll
                for (int e = 0; e < 4; ++e) {
                    const int ri = 4 * sg + e;
                    const float xr = xrv[ct][ri];
                    const float rg = sigmoid_f(dA[ri] + p_ba[ct]), ig = sigmoid_f(dX[ri] + p_bx[ct]);
                    const float la = p_c[ct] * rg, av = __builtin_amdgcn_exp2f(la * LOG2E);
                    const float uv = __builtin_amdgcn_sqrtf(one_minus_exp(2.0f * la, av)) * (ig * xr);
                    hrun = av * hrun + uv; prun *= av; hl[ri] = hrun; P[ri] = prun;
                }
                As[sg] = prun; Hs[sg] = hrun;
            }
            float cin[4], pin[4]; float cr = cur[ct], ap_ = aprod[ct];
#pragma unroll
            for (int sg = 0; sg < 4; ++sg) {
                const float Ao = __shfl_xor(As[sg], 32), Ho = __shfl_xor(Hs[sg], 32);
                const float Alo = hi ? Ao : As[sg], Hlo = hi ? Ho : Hs[sg], Ahi = hi ? As[sg] : Ao, Hhi = hi ? Hs[sg] : Ho;
                const float clo = cr, chi = Alo * clo + Hlo; cr = Ahi * chi + Hhi; cin[sg] = hi ? chi : clo;
                const float plo = ap_, phi = plo * Alo; ap_ = phi * Ahi; pin[sg] = hi ? phi : plo;
            }
            cur[ct] = cr; aprod[ct] = ap_;
#pragma unroll
            for (int sg = 0; sg < 4; ++sg)
#pragma unroll
                for (int e = 0; e < 4; ++e) { const int ri = 4 * sg + e; const int lo_ = (8 * sg + 4 * hi + e) * SC_P + chl * 2;
                    const float h = hl[ri] + P[ri] * cin[sg], pc_ = P[ri] * pin[sg];
                    const float gt = bf2f(*(const LAS bf16*)(wl + SC_GT + lo_));
                    const float z = 0.7978845608f * (gt + 0.044715f * gt * gt * gt);
                    const float ge = gt * __builtin_amdgcn_rcpf(1.0f + __builtin_amdgcn_exp2f(z * (-2.0f * LOG2E)));
                    *(LAS bf16*)(wl + SC_GT + lo_) = (bf16)(pk_bf16(ge * h, 0.f) & 0xffffu);
                    *(LAS bf16*)(wl + SC_OT + lo_) = (bf16)(pk_bf16(ge * pc_, 0.f) & 0xffffu); }
            asm volatile("" ::: "memory");
        }
        asm volatile("" ::: "memory");
#pragma unroll
        for (int j = 0; j < 4; ++j) { const int pid = lane + 64 * j, row = pid >> 3, pc = pid & 7; const unsigned grow = (unsigned)(rowbase + t0 + 32 * tt + row);
            const u32x4 v1 = *(const LAS u32x4*)(wl + SC_GT + row * SC_P + pc * 16), v2 = *(const LAS u32x4*)(wl + SC_OT + row * SC_P + pc * 16);
            *(u32x4*)((char*)mixin + (grow * D + 512u + 64u * n + 8u * pc) * 2u) = v1;
            *(u32x4*)((char*)gpb + (grow * 512u + 64u * n + 8u * pc) * 2u) = v2; }
        asm volatile("" ::: "memory");
    }
#undef SC_LOADS
    if (hi == 0) {
#pragma unroll
        for (int ct = 0; ct < 2; ++ct) { const size_t o = ((size_t)(b * 64 + c)) * 512 + 64 * n + 32 * ct + r32; cA[o] = aprod[ct]; cH[o] = cur[ct]; } }
}
__device__ __forceinline__ void scan_fix(int u, const float* cA, const float* cH, bf16* mixin, const bf16* gpb, int lane) {
    const int b = u >> 8, c = (u >> 2) & 63, q4 = u & 3;
    if (c == 0) return;
    float cr[8];
#pragma unroll
    for (int e = 0; e < 8; ++e) cr[e] = 0.f;
#pragma unroll 4
    for (int j = 0; j < c; ++j) { const unsigned o = (unsigned)((b * 64 + j) * 512 + 8 * lane) * 4u;
        const f32x4 a0 = *(const f32x4*)((const char*)cA + o), a1 = *(const f32x4*)((const char*)cA + o + 16), h0 = *(const f32x4*)((const char*)cH + o), h1 = *(const f32x4*)((const char*)cH + o + 16);
        cr[0] = a0.x * cr[0] + h0.x; cr[1] = a0.y * cr[1] + h0.y; cr[2] = a0.z * cr[2] + h0.z; cr[3] = a0.w * cr[3] + h0.w;
        cr[4] = a1.x * cr[4] + h1.x; cr[5] = a1.y * cr[5] + h1.y; cr[6] = a1.z * cr[6] + h1.z; cr[7] = a1.w * cr[7] + h1.w; }
#pragma unroll 4
    for (int r = 0; r < 16; ++r) { const unsigned row = (unsigned)(b * S + c * 64 + q4 * 16 + r);
        char* mp = (char*)mixin + (row * D + 512u + 8u * lane) * 2u;
        const u32x4 o1 = *(const u32x4*)mp, g = *(const u32x4*)((const char*)gpb + (row * 512u + 8u * lane) * 2u);
        u32x4 w;
#pragma unroll
        for (int e = 0; e < 4; ++e) { const float lo_ = __uint_as_float(o1[e] << 16) + __uint_as_float(g[e] << 16) * cr[2 * e], hi_ = __uint_as_float(o1[e] & 0xffff0000u) + __uint_as_float(g[e] & 0xffff0000u) * cr[2 * e + 1]; w[e] = pk_bf16(lo_, hi_); }
        *(u32x4*)mp = w; }
}

namespace att {
typedef LAS const char* lds_cptr;
typedef short v4i16_t __attribute__((ext_vector_type(4)));
constexpr int SLOT = 16384, LDS_K = 0, LDS_V = 2 * SLOT, LDS_X = 4 * SLOT;
__device__ __forceinline__ int crow(int r, int hi) { return (r & 3) + 8 * (r >> 2) + 4 * hi; }
__device__ __forceinline__ void glds16(const void* gsrc, unsigned lds_dst) { unsigned keep;
    asm volatile("s_mov_b32 %0, m0\n\ts_mov_b32 m0, %2\n\ts_nop 0\n\tglobal_load_lds_dwordx4 %1, off\n\ts_mov_b32 m0, %0" : "=&s"(keep) : "v"(gsrc), "s"(lds_dst) : "memory"); }
__device__ __forceinline__ s16x4 vtr(lds_cptr p) { return __builtin_bit_cast(s16x4, __builtin_amdgcn_ds_read_tr16_b64_v4i16((LAS v4i16_t*)p)); }
__device__ __forceinline__ float fadd_s(float a_, float b_) { float r_; asm("v_add_f32_e32 %0, %1, %2" : "=v"(r_) : "v"(a_), "v"(b_)); return r_; }
__device__ __forceinline__ float swap_max(float m) { auto rr = __builtin_amdgcn_permlane32_swap(__float_as_uint(m), __float_as_uint(m), false, false); return __builtin_fmaxf(__uint_as_float(rr[0]), __uint_as_float(rr[1])); }
__device__ __forceinline__ float swap_sum(float m) { auto rr = __builtin_amdgcn_permlane32_swap(__float_as_uint(m), __float_as_uint(m), false, false); return __uint_as_float(rr[0]) + __uint_as_float(rr[1]); }

__device__ __forceinline__ void attn_unit(int b, int h, int qb, int kt_min, const bf16* proj, bf16* mixin, char* shm, float lam, const float* hng) {
    int tid_l = threadIdx.x; asm volatile("" : "+v"(tid_l));
    const int tid = tid_l, lane = tid & 63, r32 = lane & 31, hi = lane >> 5; const int wid = __builtin_amdgcn_readfirstlane(tid >> 6);
    const int qg = wid & 3, mp = wid >> 2;
    const size_t rowbase = (size_t)b * S; const int q0 = qb * 128;
    const float slope2 = __builtin_amdgcn_exp2f(-2.0f * (float)(h + 1)) * LOG2E;
    const unsigned lds0 = (unsigned)(uintptr_t)shm; const lds_cptr shm3 = (lds_cptr)shm;
    const bf16* ksrc = proj + (rowbase + lane) * NIN + 512 + h * 128 + wid * 8;
    const bf16* vsrc = proj + (rowbase + 16 * (wid & 3) + (lane >> 2)) * NIN + 1024 + h * 128 + (wid >> 2) * 32 + (lane & 3) * 8;
    const unsigned kdst = lds0 + LDS_K + wid * 1024, vdst = lds0 + LDS_V + wid * 1024;
#define ATT_DMA_CUR(slot) do { \
        glds16(kcur, (unsigned)__builtin_amdgcn_readfirstlane(kdst + (slot))); glds16(kcur + 64, (unsigned)__builtin_amdgcn_readfirstlane(kdst + (slot) + 8192)); \
        glds16(vcur, (unsigned)__builtin_amdgcn_readfirstlane(vdst + (slot))); glds16(vcur + 64, (unsigned)__builtin_amdgcn_readfirstlane(vdst + (slot) + 8192)); \
        kcur -= (size_t)64 * NIN; vcur -= (size_t)64 * NIN; } while (0)
    const int NT = 2 * qb + 2, mylast = 2 * qb + (qg >> 1);
    const bf16* kcur = ksrc + (size_t)(NT - 1) * 64 * NIN; const bf16* vcur = vsrc + (size_t)(NT - 1) * 64 * NIN;
    ATT_DMA_CUR(0);
    bf16x8 qr[4];
    { const bf16* Qw = proj + (rowbase + q0 + qg * 32 + r32) * NIN + h * 128 + mp * 64 + hi * 8;
#pragma unroll
      for (int d0 = 0; d0 < 4; ++d0) qr[d0] = *(const bf16x8*)(Qw + d0 * 16); }
    const lds_cptr kp0 = shm3 + LDS_K + mp * 8192 + hi * 1024 + r32 * 16;
    const lds_cptr vp0 = shm3 + LDS_V + ((lane >> 4) & 1) * 32 + (lane & 3) * 8 + (4 * hi + ((lane & 15) >> 2)) * 64;
    float mref = 0.f, lsum = 0.f; f32x16 o[4];
#pragma unroll
    for (int dq = 0; dq < 4; ++dq) o[dq] = f32x16{};
    float cr[16];
#pragma unroll
    for (int r = 0; r < 16; ++r) cr[r] = slope2 * (float)((r & 3) + 8 * (r >> 2));
    const int qpos = q0 + qg * 32 + r32 - 4 * hi;
    const int NTW = NT - kt_min;
    for (int i = 0; i < NTW; ++i) {
        const int kt = NT - 1 - i, sl = (i & 1) * SLOT;
        asm volatile("s_waitcnt vmcnt(0)\n\ts_barrier" ::: "memory");
        if (i + 1 < NTW) ATT_DMA_CUR(SLOT - sl);
        if (kt <= mylast) {
            f32x16 p0, p1;
            const float dqf = (float)(qpos - 64 * kt);
            if (kt < mylast) {
                const float lb0 = -slope2 * dqf - mref, lb1 = lb0 + 32.0f * slope2;
#pragma unroll
                for (int r = 0; r < 16; ++r) { p0[r] = cr[r] + lb0; p1[r] = cr[r] + lb1; }
            } else {
#pragma unroll
                for (int r = 0; r < 16; ++r) { const float ko = (float)((r & 3) + 8 * (r >> 2));
                    p0[r] = __builtin_fmaf(-slope2, __builtin_fabsf(dqf - ko), -mref); p1[r] = __builtin_fmaf(-slope2, __builtin_fabsf(dqf - (ko + 32.0f)), -mref); }
            }
            const lds_cptr kp = kp0 + sl;
#pragma unroll
            for (int d0 = 0; d0 < 4; ++d0) {
                const bf16x8 a0 = *(const LAS bf16x8*)(kp + d0 * 2048), a1 = *(const LAS bf16x8*)(kp + d0 * 2048 + 512);
                p0 = __builtin_amdgcn_mfma_f32_32x32x16_bf16(a0, qr[d0], p0, 0, 0, 0);
                p1 = __builtin_amdgcn_mfma_f32_32x32x16_bf16(a1, qr[d0], p1, 0, 0, 0);
            }
#define MX3(a_, b_, c_) __builtin_fmaxf(__builtin_fmaxf((a_), (b_)), (c_))
            float ra = MX3(p0[0], p0[1], p1[0]), rb = MX3(p0[2], p0[3], p1[1]); ra = MX3(ra, p1[2], p1[3]);
#pragma unroll
            for (int r = 4; r < 16; r += 4) { ra = MX3(ra, p0[r], p0[r + 1]); rb = MX3(rb, p0[r + 2], p0[r + 3]); ra = MX3(ra, p1[r], p1[r + 1]); rb = MX3(rb, p1[r + 2], p1[r + 3]); }
#undef MX3
            const float rm = swap_max(__builtin_fmaxf(ra, rb));
            if (__any(rm > 8.0f)) {
                const float dl = __builtin_fmaxf(rm, 0.f), alpha = __builtin_amdgcn_exp2f(-dl);
                mref += dl; lsum *= alpha;
#pragma unroll
                for (int r = 0; r < 16; ++r) { p0[r] -= dl; p1[r] -= dl; }
#pragma unroll
                for (int dq = 0; dq < 4; ++dq)
#pragma unroll
                    for (int r = 0; r < 16; ++r) o[dq][r] *= alpha;
            }
#pragma unroll
            for (int r = 0; r < 16; ++r) { p0[r] = __builtin_amdgcn_exp2f(p0[r]); p1[r] = __builtin_amdgcn_exp2f(p1[r]); }
            { float sa = fadd_s(p0[0], p1[0]), sb = fadd_s(p0[1], p1[1]), sc = fadd_s(p0[2], p1[2]), sd = fadd_s(p0[3], p1[3]);
#pragma unroll
              for (int r = 4; r < 16; r += 4) { sa = fadd_s(sa, fadd_s(p0[r], p1[r])); sb = fadd_s(sb, fadd_s(p0[r + 1], p1[r + 1])); sc = fadd_s(sc, fadd_s(p0[r + 2], p1[r + 2])); sd = fadd_s(sd, fadd_s(p0[r + 3], p1[r + 3])); }
              lsum += fadd_s(fadd_s(sa, sb), fadd_s(sc, sd)); }
            bf16x8 pf[4];
#pragma unroll
            for (int s = 0; s < 2; ++s) {
                u32x4 w0, w1;
                w0.x = pk_bf16(p0[8 * s + 0], p0[8 * s + 1]); w0.y = pk_bf16(p0[8 * s + 2], p0[8 * s + 3]); w0.z = pk_bf16(p0[8 * s + 4], p0[8 * s + 5]); w0.w = pk_bf16(p0[8 * s + 6], p0[8 * s + 7]);
                w1.x = pk_bf16(p1[8 * s + 0], p1[8 * s + 1]); w1.y = pk_bf16(p1[8 * s + 2], p1[8 * s + 3]); w1.z = pk_bf16(p1[8 * s + 4], p1[8 * s + 5]); w1.w = pk_bf16(p1[8 * s + 6], p1[8 * s + 7]);
                pf[s] = __builtin_bit_cast(bf16x8, w0); pf[2 + s] = __builtin_bit_cast(bf16x8, w1);
            }
            const lds_cptr vp = vp0 + sl;
            s16x4 vlo[2][4], vup[2][4];
#pragma unroll
            for (int ks = 0; ks < 4; ++ks) { vlo[0][ks] = vtr(vp + ks * 1024); vup[0][ks] = vtr(vp + ks * 1024 + 512); }
#pragma unroll
            for (int dq = 0; dq < 4; ++dq) {
                if (dq < 3) {
#pragma unroll
                    for (int ks = 0; ks < 4; ++ks) { vlo[(dq + 1) & 1][ks] = vtr(vp + (dq + 1) * 4096 + ks * 1024); vup[(dq + 1) & 1][ks] = vtr(vp + (dq + 1) * 4096 + ks * 1024 + 512); } }
#pragma unroll
                for (int ks = 0; ks < 4; ++ks) {
                    const s16x4 lo = vlo[dq & 1][ks], up = vup[dq & 1][ks];
                    const bf16x8 vf = (bf16x8){lo[0], lo[1], lo[2], lo[3], up[0], up[1], up[2], up[3]};
                    o[dq] = __builtin_amdgcn_mfma_f32_32x32x16_bf16(vf, pf[ks], o[dq], 0, 0, 0);
                }
                __builtin_amdgcn_sched_barrier(0);
            }
        }
    }
#undef ATT_DMA_CUR
    const float inv = 1.0f / swap_sum(lsum);
    LAS float* X = (LAS float*)(shm3 + LDS_X + qg * 16384);
    if (mp == 1) { const float sc = inv * lam;
#pragma unroll
        for (int dq = 0; dq < 4; ++dq)
#pragma unroll
            for (int r = 0; r < 16; ++r) X[(32 * dq + crow(r, hi)) * 32 + r32] = o[dq][r] * sc; }
    asm volatile("s_waitcnt lgkmcnt(0)\n\ts_barrier" ::: "memory");
    if (mp == 0) {
        float ss = 0.f;
#pragma unroll
        for (int dq = 0; dq < 4; ++dq)
#pragma unroll
            for (int r = 0; r < 16; ++r) { const float v = o[dq][r] * inv - X[(32 * dq + crow(r, hi)) * 32 + r32]; o[dq][r] = v; ss += v * v; }
        ss = swap_sum(ss);
        const float rstd = __builtin_amdgcn_rsqf(ss * (1.0f / 128.0f) + EPS) * 0.8f;
        asm volatile("s_waitcnt lgkmcnt(0)" ::: "memory");
        LAS unsigned char* stg = (LAS unsigned char*)X;
#pragma unroll
        for (int dq = 0; dq < 4; ++dq)
#pragma unroll
            for (int g4 = 0; g4 < 4; ++g4) { const int dv0 = 32 * dq + 8 * g4 + 4 * hi; const f32x4 gg = *(const f32x4*)(hng + dv0);
                u32x2 w; w.x = pk_bf16(o[dq][4 * g4 + 0] * rstd * gg.x, o[dq][4 * g4 + 1] * rstd * gg.y); w.y = pk_bf16(o[dq][4 * g4 + 2] * rstd * gg.z, o[dq][4 * g4 + 3] * rstd * gg.w);
                *(LAS u32x2*)(stg + r32 * 272 + dv0 * 2) = w; }
        asm volatile("s_waitcnt lgkmcnt(0)" ::: "memory");
        bf16* Ow = mixin + (rowbase + q0 + qg * 32) * D + h * 128;
#pragma unroll
        for (int i = 0; i < 8; ++i) { const int row = i * 4 + (lane >> 4), chn = lane & 15; const u32x4 v = *(const LAS u32x4*)(stg + row * 272 + chn * 16); *(u32x4*)(Ow + (size_t)row * D + chn * 8) = v; }
        asm volatile("s_waitcnt lgkmcnt(0)" ::: "memory");
    }
}
}

#define GAS __attribute__((address_space(1)))
#define XB_TMO      128
#define XB_XCNT(j)  (256  + 64 * (j))
#define XB_XSUB(j)  (1280 + 64 * (j))
#define XB_XGEN(j)  (2304 + 64 * (j))
#define XB_TOP      3328
#define XB_TOPGEN   3392
#define XCD_BAR_WORDS 3456
#define XB_SPIN_CAP (1u << 18)

__device__ __forceinline__ unsigned xb_ld(unsigned* p)              { return __hip_atomic_load(p, __ATOMIC_RELAXED, __HIP_MEMORY_SCOPE_AGENT); }
__device__ __forceinline__ unsigned xb_add(unsigned* p, unsigned v) { return __hip_atomic_fetch_add(p, v, __ATOMIC_RELAXED, __HIP_MEMORY_SCOPE_AGENT); }
__device__ __forceinline__ unsigned xb_xcc_id() { return (unsigned)__builtin_amdgcn_s_getreg((3 << 11) | 20) & 0xFu; }
#define XB_SPIN(cond, bar) do { unsigned _sp = 0; while (cond) { __builtin_amdgcn_s_sleep(1); \
    if ((++_sp & 255u) == 0u) { if (xb_ld(&(bar)[XB_TMO])) break; if (_sp > XB_SPIN_CAP) { atomicAdd(&(bar)[XB_TMO], 1u); break; } } } } while (0)

struct XcdBarrier {
    unsigned* bar; unsigned x;
    volatile LAS unsigned* st;
};

__device__ __forceinline__ XcdBarrier xcd_barrier_post(unsigned* bar, volatile LAS unsigned* st) {
    XcdBarrier b; b.bar = bar; b.x = xb_xcc_id(); b.st = st;
    if (threadIdx.x == 0) (void)xb_add(&bar[XB_XCNT(b.x)], 1u);
    return b;
}
__device__ __forceinline__ void xcd_barrier_complete(unsigned* bar, unsigned x, unsigned& nloc, unsigned& nx) {
    const unsigned G = gridDim.x * gridDim.y * gridDim.z;
    unsigned sum, cnt, mine, sp = 0u;
    for (;;) {
        sum = 0u; cnt = 0u; mine = 0u;
#pragma unroll
        for (unsigned j = 0; j < 16; ++j) { const unsigned c = xb_ld(&bar[XB_XCNT(j)]); sum += c; cnt += (c > 0u) ? 1u : 0u; mine = (j == x) ? c : mine; }
        if (sum == G) break;
        __builtin_amdgcn_s_sleep(1);
        if ((++sp & 255u) == 0u) { if (xb_ld(&bar[XB_TMO])) break; if (sp > XB_SPIN_CAP) { atomicAdd(&bar[XB_TMO], 1u); break; } }
    }
    nloc = mine > 0u ? mine : 1u; nx = cnt > 0u ? cnt : 1u;
}

__device__ __forceinline__ void xcd_barrier(const XcdBarrier& b) {
    asm volatile("s_waitcnt vmcnt(0)" ::: "memory");
    __syncthreads();
    if (threadIdx.x == 0) {
        unsigned* bar = b.bar;
        __builtin_amdgcn_s_waitcnt(0);
        unsigned nloc = b.st[0], nx = b.st[1];
        if (nloc == 0u) { xcd_barrier_complete(bar, b.x, nloc, nx); b.st[0] = nloc; b.st[1] = nx; }
        const unsigned old = xb_add(&bar[XB_XSUB(b.x)], 1u);
        const unsigned gen = old / nloc;
        if (old + 1u == (gen + 1u) * nloc) {
            __builtin_amdgcn_fence(__ATOMIC_RELEASE, "agent");
            asm volatile("s_waitcnt vmcnt(0)" ::: "memory");
            const unsigned og = xb_add(&bar[XB_TOP], 1u);
            const unsigned tg = og / nx;
            if (og + 1u == (tg + 1u) * nx) xb_add(&bar[XB_TOPGEN], 1u);
            else XB_SPIN(xb_ld(&bar[XB_TOPGEN]) == tg, bar);
            __builtin_amdgcn_fence(__ATOMIC_ACQUIRE, "agent");
            xb_add(&bar[XB_XGEN(b.x)], 1u);
            asm volatile("s_waitcnt vmcnt(0)" ::: "memory");
        } else {
            XB_SPIN(xb_ld(&bar[XB_XGEN(b.x)]) == gen, bar);
            __builtin_amdgcn_fence(__ATOMIC_ACQUIRE, "agent");
            asm volatile("s_waitcnt vmcnt(0)" ::: "memory");
        }
    }
    __syncthreads();
}

__global__ void __launch_bounds__(512) fwd_mega(Args a) {
    extern __shared__ __attribute__((aligned(16))) unsigned char lds_raw[];
    cg::grid_group grid = cg::this_grid();
    LAS unsigned char* lds = (LAS unsigned char*)lds_raw;
    const int tid0 = threadIdx.x;
    const int G = gridDim.x;
    unsigned char* ws = a.ws;
    float* mod = (float*)(ws + WS_MOD); float* cA = (float*)(ws + WS_CA); float* cH = (float*)(ws + WS_CH);
    bf16* wrg = (bf16*)(ws + WS_WRG);
    bf16* hbuf = (bf16*)(ws + WS_HBUF); bf16* mixin = (bf16*)(ws + WS_MIX); bf16* x1b = (bf16*)(ws + WS_X1);
    bf16* hid = (bf16*)(ws + WS_R1); bf16* proj = (bf16*)(ws + WS_R1);
    float* ssq0 = (float*)(ws + WS_SSQ); float* ssq1 = ssq0 + (size_t)M * 16; float* ssq2 = ssq1 + (size_t)M * 16; float* sW = (float*)(ws + WS_SW);
    const int lo = a.ph_lo, hi_ph = a.ph_hi;
    unsigned* barw = (unsigned*)(ws + WS_BAR);
    volatile LAS unsigned* bst = (volatile LAS unsigned*)(lds + LDS_BYTES - 16);
    if (tid0 < 4) bst[tid0] = 0u;
    if (blockIdx.x == 0) { for (int i = tid0; i < XCD_BAR_WORDS; i += 512) __hip_atomic_store(barw + i, 0u, __ATOMIC_RELAXED, __HIP_MEMORY_SCOPE_AGENT); }
    unsigned* qctr = (unsigned*)(ws + WS_QCTR);
    if (blockIdx.x == 0 && tid0 < 512) __hip_atomic_store(qctr + tid0, 0u, __ATOMIC_RELAXED, __HIP_MEMORY_SCOPE_AGENT);
    XcdBarrier xbar; xbar.bar = barw; xbar.x = 0; xbar.st = bst;
#ifndef PH_MASK
#define PH_MASK 0xFFF
#endif
#define IN(k) (((PH_MASK >> (k)) & 1) && lo <= (k) && (k) < hi_ph)
#define SEAM(k) do { if (IN(k) && IN((k) + 1)) { if ((k) == 0) { grid.sync(); xbar = xcd_barrier_post(barw, bst); } else xcd_barrier(xbar); } } while (0)
#ifndef REP_MASK
#define REP_MASK 0
#endif
#define REP(k) for (int rep_ = 0; rep_ <= ((REP_MASK >> (k)) & 1); ++rep_)

#define LW() int t_ = threadIdx.x; asm volatile("" : "+v"(t_)); const int tid = t_, lane = t_ & 63, wave = __builtin_amdgcn_readfirstlane(t_ >> 6); (void)tid; (void)lane; (void)wave
    REP(0) if (IN(0)) { if (rep_) grid.sync(); LW(); p0_prologue(a, lds, tid, lane, wave, G); } SEAM(0);
    if ((REP_MASK >> 14) & 1) { for (int q_ = 0; q_ < 10; ++q_) grid.sync(); }
    REP(1) if (IN(1)) { if (rep_) grid.sync(); LW(); p1_phase(a.in[0], hbuf, ssq0, a.in[4], mod, (const bf16*)(ws + WS_WUP1), (const bf16*)(ws + WS_WIN), (const bf16*)(ws + WS_WUP2), sW, lane, wave, G); } SEAM(1);
    REP(2) if (IN(2)) { if (rep_) grid.sync(); pg8::Gemm g{hbuf, (const bf16*)(ws + WS_WUP1), M, 2 * FF, D}; pg8::StaticOrder So; So.init(M, 2 * FF, G, (int)blockIdx.x);
        pg8::EpiSwiglu E{hid, ssq0, sW}; pg8::gemm_phase<pg8::EpiSwiglu, pg8::StaticOrder, true, true>(lds, g, So, E); } SEAM(2);
    REP(3) if (IN(3)) { if (rep_) grid.sync(); pg8::Gemm g{hid, (const bf16*)(ws + WS_WDN1), M, D, FF}; pg8::StaticOrder So; So.init(M, D, G, (int)blockIdx.x);
        pg8::EpiResid<true, true, false, true> E{a.in[0], x1b, mod + 0 * 3072 + 2048, hbuf, ssq1, a.in[4] + 1024, mod + 3072 + 1024}; pg8::gemm_phase<pg8::EpiResid<true, true, false, true>, pg8::StaticOrder, true, true>(lds, g, So, E); } SEAM(3);
    REP(5) if (IN(5)) { if (rep_) grid.sync(); pg8::Gemm g{hbuf, (const bf16*)(ws + WS_WIN), M, NIN, D}; pg8::StaticOrder So; So.init(M, NIN, G, (int)blockIdx.x);
        pg8::EpiWin E{proj, a.in[9], a.in[10], ssq1, sW + 8 * 5632}; pg8::gemm_phase<pg8::EpiWin, pg8::StaticOrder, true, true>(lds, g, So, E); } SEAM(5);
    REP(6) if (IN(6)) { if (rep_) grid.sync(); LW();
        for (int wu = blockIdx.x; wu < NB * 64; wu += G) scan_pass1(wu >> 6, wu & 63, wave, proj, wrg, a.in[13], a.in[14], a.in[16], a.in[18], a.in[19], cA, cH, mixin, hbuf, lds + wave * SC_WAVE, lane);
        asm volatile("s_waitcnt vmcnt(0) lgkmcnt(0)" ::: "memory"); __syncthreads();
        }
    REP(7) if (IN(7)) { if (rep_) grid.sync(); LW();
        float lam;
        { const float* lp = a.in[11]; const float s1 = wave_sum(lp[lane] * lp[64 + lane]), s2 = wave_sum(lp[128 + lane] * lp[192 + lane]); lam = expf(s1) - expf(s2) + 0.2f; }
#ifndef NO_ATT
        float Bs2;
        { const float gqm = __builtin_fmaxf(__builtin_fabsf(a.in[9][lane]), __builtin_fabsf(a.in[9][64 + lane])), gkm = __builtin_fmaxf(__builtin_fabsf(a.in[10][lane]), __builtin_fabsf(a.in[10][64 + lane]));
          float mq = gqm, mk = gkm;
#pragma unroll
          for (int o_ = 1; o_ < 64; o_ <<= 1) { mq = __builtin_fmaxf(mq, __shfl_xor(mq, o_)); mk = __builtin_fmaxf(mk, __shfl_xor(mk, o_)); }
          Bs2 = 16.0f * mq * mk + 25.0f; }
        volatile LAS unsigned* qslot = (volatile LAS unsigned*)(lds + LDS_BYTES - 32);
        bool published = false;
        const int q_home = (int)(xb_xcc_id() & 7u);
        for (int repa_ = 0; repa_ <= ((REP_MASK >> 12) & 1); ++repa_)
        for (int dq_ = 0; dq_ < 8; ++dq_) {
            const int qi = (q_home + dq_) & 7;
            for (;;) {
                if (tid == 0) qslot[0] = atomicAdd(qctr + 64 * qi + 16 * repa_, 1u);
                asm volatile("s_waitcnt vmcnt(0) lgkmcnt(0)\n\ts_barrier" ::: "memory");
                const unsigned uu = qslot[0];
                asm volatile("s_waitcnt lgkmcnt(0)\n\ts_barrier" ::: "memory");
                if (uu >= 128u) break;
                const int qb = 31 - (int)(uu >> 2), h = (int)(uu & 3u);
                const float Wh = Bs2 * __builtin_amdgcn_exp2f(2.0f * (float)(h + 1));
                int ktm = (int)(((float)(qb * 128) - Wh - 0.5f) * (1.0f / 64.0f)); if (ktm < 0) ktm = 0;
                att::attn_unit(qi, h, qb, ktm, proj, mixin, (char*)lds_raw, lam, a.in[12]);
                if (!published) { published = true;
                    asm volatile("s_waitcnt vmcnt(0)" ::: "memory"); __syncthreads();
                    if (tid == 0) { __builtin_amdgcn_fence(__ATOMIC_RELEASE, "agent"); asm volatile("s_waitcnt vmcnt(0)" ::: "memory"); (void)xb_add(qctr + 480, 1u); } }
            }
        }
        if (!published) { asm volatile("s_waitcnt vmcnt(0)" ::: "memory"); __syncthreads();
            if (tid == 0) { __builtin_amdgcn_fence(__ATOMIC_RELEASE, "agent"); asm volatile("s_waitcnt vmcnt(0)" ::: "memory"); (void)xb_add(qctr + 480, 1u); } }
#endif
#ifndef NO_SCANF
        const int gw = blockIdx.x * NWAVES + wave, NGW = G * NWAVES;
        if (tid == 0) { unsigned sp_ = 0;
            while (xb_ld(qctr + 480) < (unsigned)G) { __builtin_amdgcn_s_sleep(1); if (++sp_ > (1u << 22)) break; }
            __builtin_amdgcn_fence(__ATOMIC_ACQUIRE, "agent"); asm volatile("s_waitcnt vmcnt(0)" ::: "memory"); }
        __syncthreads();
        for (int reps_ = 0; reps_ <= ((REP_MASK >> 13) & 1); ++reps_)
        for (int u = gw; u < 2048; u += NGW) scan_fix(u, cA, cH, mixin, hbuf, lane);
#endif
        asm volatile("s_waitcnt vmcnt(0) lgkmcnt(0)" ::: "memory"); __syncthreads();
    } SEAM(7);
    REP(8) if (IN(8)) { if (rep_) grid.sync(); pg8::Gemm g{mixin, (const bf16*)(ws + WS_WOUT), M, D, D}; pg8::StaticOrder So; So.init(M, D, G, (int)blockIdx.x);
        pg8::EpiResid<true, false, true, true> E{x1b, x1b, mod + 1 * 3072 + 2048, hbuf, ssq2, a.in[4] + 2048, mod + 6144 + 1024}; pg8::gemm_phase<pg8::EpiResid<true, false, true, true>, pg8::StaticOrder, true, true>(lds, g, So, E); } SEAM(8);
    REP(10) if (IN(10)) { if (rep_) grid.sync(); pg8::Gemm g{hbuf, (const bf16*)(ws + WS_WUP2), M, 2 * FF, D}; pg8::StaticOrder So; So.init(M, 2 * FF, G, (int)blockIdx.x);
        pg8::EpiSwiglu E{hid, ssq2, sW + 8 * 5632 + 8 * 2560}; pg8::gemm_phase<pg8::EpiSwiglu, pg8::StaticOrder, true, true>(lds, g, So, E); } SEAM(10);
    REP(11) if (IN(11)) { if (rep_) grid.sync(); pg8::Gemm g{hid, (const bf16*)(ws + WS_WDN2), M, D, FF}; pg8::StaticOrder So; So.init(M, D, G, (int)blockIdx.x);
        pg8::EpiResid<false, true, true, false> E{x1b, a.out, mod + 2 * 3072 + 2048, nullptr, nullptr, nullptr, nullptr}; pg8::gemm_phase<pg8::EpiResid<false, true, true, false>, pg8::StaticOrder, true, true>(lds, g, So, E); }
#undef IN
#undef SEAM
}

extern "C" void kernel_launch(void* const* d_in, const int* in_sizes, int n_in, void* d_out, int out_size, void* d_ws, size_t ws_size, hipStream_t stream) {
    static int grid = 0;
    if (grid == 0) {
        if (n_in != 24 || in_sizes[0] != M * D || out_size != M * D || ws_size < WS_END) { fprintf(stderr, "kernel_launch: unexpected shapes (n_in %d, in0 %d, out %d, ws %zu); nothing launched\n", n_in, n_in > 0 ? in_sizes[0] : -1, out_size, ws_size); grid = -1; return; }
        int dev = 0, cus = 0, per_cu = 0;
        if (hipGetDevice(&dev) != hipSuccess || hipDeviceGetAttribute(&cus, hipDeviceAttributeMultiprocessorCount, dev) != hipSuccess) { grid = -1; return; }
        if (hipFuncSetAttribute((const void*)fwd_mega, hipFuncAttributeMaxDynamicSharedMemorySize, LDS_BYTES) != hipSuccess) { fprintf(stderr, "kernel_launch: hipFuncSetAttribute failed\n"); grid = -1; return; }
        if (hipOccupancyMaxActiveBlocksPerMultiprocessor(&per_cu, (const void*)fwd_mega, NWAVES * 64, LDS_BYTES) != hipSuccess || per_cu < 1) { fprintf(stderr, "kernel_launch: occupancy query says %d blocks per CU\n", per_cu); (void)hipGetLastError(); grid = -1; return; }
        grid = cus * per_cu;
        if (grid > 256) grid = 256;
    }
    if (grid < 0) return;
    Args a{};
    for (int i = 0; i < 24; ++i) a.in[i] = (const float*)d_in[i];
    a.out = (float*)d_out; a.ws = (unsigned char*)d_ws; a.ph_lo = 0; a.ph_hi = 12;
    void* kargs[] = {&a};
    hipError_t e = hipLaunchCooperativeKernel((const void*)fwd_mega, dim3(grid), dim3(NWAVES * 64), kargs, LDS_BYTES, stream);
    if (e != hipSuccess) fprintf(stderr, "kernel_launch: cooperative launch failed: %s (grid %d)\n", hipGetErrorString(e), grid);
}
```
